# Optimizing an MI355X kernel written in HIP

```python
import math
import jax, jax.numpy as jnp
from jax import lax
import numpy as np

D_MODEL = 1024
BATCH = 8
SEQ = 4096
DEPTH = 1

MOBA_HEADS = 8
MOBA_HEAD_DIM = 64
MOBA_WIDTH = MOBA_HEADS * MOBA_HEAD_DIM
MOBA_BLOCK = 256
MOBA_TOPK = 3
MOBA_Q_CHUNK = 16
ROPE_THETA = 10000.0

GLA_HEADS = 4
GLA_DK = D_MODEL // 4
GLA_DV = D_MODEL // 2
GLA_HEAD_K = GLA_DK // GLA_HEADS
GLA_HEAD_V = GLA_DV // GLA_HEADS
GLA_GATE_RANK = 16
GLA_GATE_NORM = 16.0
GLA_CHUNK = 64

N_BRANCH = 2
RMS_EPS = 1e-6
NEG_INF = -1e30

IN_SPLITS = (
    MOBA_WIDTH, MOBA_WIDTH, MOBA_WIDTH, MOBA_WIDTH,
    GLA_DK, GLA_DK, GLA_DV, GLA_DV,
    GLA_GATE_RANK,
    D_MODEL, D_MODEL,
)
N_IN = sum(IN_SPLITS)

kernel_name = "hybrid_moba_gla_gated_merge"


def rms_norm(x, g):
    xf = x.astype(jnp.float32)
    y = xf * lax.rsqrt(jnp.mean(xf * xf, axis=-1, keepdims=True) + RMS_EPS)
    return (y * g.astype(jnp.float32)).astype(x.dtype)


def rotary(t):
    S, dh = t.shape[2], t.shape[3]
    half = dh // 2
    inv_freq = 1.0 / (ROPE_THETA ** (jnp.arange(half, dtype=jnp.float32) / half))
    ang = jnp.arange(S, dtype=jnp.float32)[:, None] * inv_freq[None, :]
    cos, sin = jnp.cos(ang), jnp.sin(ang)
    tf = t.astype(jnp.float32)
    t1, t2 = tf[..., :half], tf[..., half:]
    return jnp.concatenate([t1 * cos - t2 * sin, t1 * sin + t2 * cos], axis=-1).astype(t.dtype)


def moba_attention(q, k, v):
    B, H, S, Dh = q.shape
    S_pad = -(-S // MOBA_BLOCK) * MOBA_BLOCK
    pad = ((0, 0), (0, 0), (0, S_pad - S), (0, 0))
    q, k, v = jnp.pad(q, pad), jnp.pad(k, pad), jnp.pad(v, pad)
    nb = S_pad // MOBA_BLOCK
    k_eff = min(MOBA_TOPK, nb)
    k_blk = k.reshape(B, H, nb, MOBA_BLOCK, Dh)
    v_blk = v.reshape(B, H, nb, MOBA_BLOCK, Dh)
    k_mean = jnp.mean(k_blk.astype(jnp.float32), axis=3)
    n_q = S_pad // MOBA_Q_CHUNK
    q_ch = q.reshape(B, H, n_q, MOBA_Q_CHUNK, Dh).transpose(2, 0, 1, 3, 4)
    scale = Dh ** -0.5
    bi = jnp.arange(B)[:, None, None, None]
    hi = jnp.arange(H)[None, :, None, None]
    blk_ids = jnp.arange(nb)

    def chunk_fn(args):
        qc, ci = args
        pos_q = ci * MOBA_Q_CHUNK + jnp.arange(MOBA_Q_CHUNK)
        own_blk = (ci * MOBA_Q_CHUNK) // MOBA_BLOCK
        gate = jnp.einsum('bhqd,bhnd->bhqn', qc.astype(jnp.float32), k_mean)
        gate = jnp.where(blk_ids < own_blk, gate, NEG_INF)
        _, top_idx = lax.top_k(gate, k_eff)
        own_idx = jnp.broadcast_to(own_blk, top_idx.shape[:-1] + (1,)).astype(top_idx.dtype)
        sel = jnp.concatenate([top_idx, own_idx], axis=-1)
        k_sel = k_blk[bi, hi, sel]
        v_sel = v_blk[bi, hi, sel]
        past_mask = jnp.broadcast_to((jnp.arange(k_eff) < own_blk)[None, :, None],
                                     (MOBA_Q_CHUNK, k_eff, MOBA_BLOCK))
        own_pos = own_blk * MOBA_BLOCK + jnp.arange(MOBA_BLOCK)
        own_mask = (own_pos[None, :] <= pos_q[:, None])[:, None, :]
        mask = jnp.concatenate([past_mask, own_mask], axis=1)
        logits = jnp.einsum('bhqd,bhqnld->bhqnl', qc, k_sel).astype(jnp.float32) * scale
        logits = jnp.where(mask, logits, NEG_INF)
        p = jax.nn.softmax(logits.reshape(B, H, MOBA_Q_CHUNK, -1), axis=-1)
        p = p.reshape(logits.shape).astype(v.dtype)
        return jnp.einsum('bhqnl,bhqnld->bhqd', p, v_sel)

    out = lax.map(chunk_fn, (q_ch, jnp.arange(n_q, dtype=jnp.int32)))
    out = out.transpose(1, 2, 0, 3, 4).reshape(B, H, S_pad, Dh)
    return out[:, :, :S]


def gla_chunked(q, k, v, g):
    B, H, S, Dk = q.shape
    Dv = v.shape[-1]
    nc = S // GLA_CHUNK

    def to_chunks(t):
        return t.astype(jnp.float32).reshape(B, H, nc, GLA_CHUNK, t.shape[-1]).transpose(2, 0, 1, 3, 4)

    causal = jnp.tril(jnp.ones((GLA_CHUNK, GLA_CHUNK), dtype=bool))

    def step(state, inp):
        qc, kc, vc, gc = inp
        b = jnp.cumsum(gc, axis=2)
        o_inter = jnp.einsum('bhtd,bhde->bhte', qc * jnp.exp(b), state)
        diff = b[:, :, :, None, :] - b[:, :, None, :, :]
        decay = jnp.exp(jnp.where(causal[:, :, None], diff, -jnp.inf))
        attn = jnp.einsum('bhtd,bhsd,bhtsd->bhts', qc, kc, decay)
        o = o_inter + jnp.einsum('bhts,bhse->bhte', attn, vc)
        b_last = b[:, :, -1:, :]
        state = (jnp.exp(b_last[:, :, 0, :])[..., None] * state
                 + jnp.einsum('bhsd,bhse->bhde', kc * jnp.exp(b_last - b), vc))
        return state, o

    state0 = jnp.zeros((B, H, Dk, Dv), jnp.float32)
    _, o = lax.scan(step, state0, (to_chunks(q), to_chunks(k), to_chunks(v), to_chunks(g)))
    return o.transpose(1, 2, 0, 3, 4).reshape(B, H, S, Dv)


def setup_inputs(seed: int = 0) -> dict:
    key = jax.random.key(seed)
    ks = jax.random.split(key, 11)
    nrm = jax.random.normal
    return {
        "x": nrm(ks[0], (BATCH, SEQ, D_MODEL), jnp.float32),
        "norm_in_g": 1.0 + 0.01 * nrm(ks[1], (DEPTH, D_MODEL), jnp.float32),
        "w_in": nrm(ks[2], (DEPTH, D_MODEL, N_IN), jnp.float32) * D_MODEL ** -0.5,
        "b_merge": 0.01 * nrm(ks[3], (DEPTH, N_BRANCH, D_MODEL), jnp.float32),
        "w_gla_fg2": nrm(ks[4], (DEPTH, GLA_GATE_RANK, GLA_DK), jnp.float32) * GLA_GATE_RANK ** -0.5,
        "b_gla_fg": 0.1 * nrm(ks[5], (DEPTH, GLA_DK), jnp.float32),
        "gla_norm_g": 1.0 + 0.01 * nrm(ks[6], (DEPTH, GLA_HEAD_V), jnp.float32),
        "w_proj_a": nrm(ks[7], (DEPTH, MOBA_WIDTH, D_MODEL), jnp.float32) * MOBA_WIDTH ** -0.5,
        "w_proj_b": nrm(ks[8], (DEPTH, GLA_DV, D_MODEL), jnp.float32) * GLA_DV ** -0.5,
        "w_out": nrm(ks[9], (DEPTH, D_MODEL, D_MODEL), jnp.float32) * D_MODEL ** -0.5,
        "norm_f_g": 1.0 + 0.01 * nrm(ks[10], (D_MODEL,), jnp.float32),
    }


def reference(x, norm_in_g, w_in, b_merge, w_gla_fg2, b_gla_fg, gla_norm_g,
              w_proj_a, w_proj_b, w_out, norm_f_g):
    B, S, _ = x.shape
    split_pts = [int(p) for p in np.cumsum(IN_SPLITS)[:-1]]

    def heads(t, n):
        return t.reshape(B, S, n, -1).transpose(0, 2, 1, 3)

    for layer in range(DEPTH):
        h = rms_norm(x, norm_in_g[layer])
        proj = jnp.einsum('bsd,de->bse', h, w_in[layer])
        (mq, mk, mv, mgate, gq, gk, gv, ggate, gfg, ga, gb) = jnp.split(proj, split_pts, axis=-1)

        qa = rotary(heads(mq, MOBA_HEADS))
        ka = rotary(heads(mk, MOBA_HEADS))
        va = heads(mv, MOBA_HEADS)
        oa = moba_attention(qa, ka, va)
        oa = oa.transpose(0, 2, 1, 3).reshape(B, S, MOBA_WIDTH) * jax.nn.silu(mgate)
        ya = jnp.einsum('bse,ed->bsd', oa, w_proj_a[layer])

        fg_logit = jnp.einsum('bsr,rk->bsk', gfg, w_gla_fg2[layer]) + b_gla_fg[layer]
        log_alpha = jax.nn.log_sigmoid(fg_logit.astype(jnp.float32)) / GLA_GATE_NORM
        qb = heads(gq, GLA_HEADS) * (GLA_HEAD_K ** -0.5)
        kb = heads(gk, GLA_HEADS)
        vb = heads(gv, GLA_HEADS)
        gdec = heads(log_alpha, GLA_HEADS)
        ob = gla_chunked(qb, kb, vb, gdec)
        ob = rms_norm(ob, gla_norm_g[layer]).astype(x.dtype)
        ob = ob.transpose(0, 2, 1, 3).reshape(B, S, GLA_DV) * jax.nn.silu(ggate)
        yb = jnp.einsum('bse,ed->bsd', ob, w_proj_b[layer])

        merged = (jax.nn.sigmoid(ga + b_merge[layer, 0]) * ya
                  + jax.nn.sigmoid(gb + b_merge[layer, 1]) * yb)
        x = x + jnp.einsum('bsd,de->bse', merged, w_out[layer])

    return rms_norm(x, norm_f_g)
```

```cpp
#include <hip/hip_runtime.h>
#include <cstdint>
#include <cstdio>

constexpr int D_MODEL = 1024, BATCH = 8, SEQ = 4096, M = BATCH * SEQ;
constexpr int N_IN = 5648;
constexpr int NBLK = 16;
constexpr int NP = 5632;
constexpr int P_MQ = 0, P_MK = 512, P_MV = 1024, P_MG = 1536, P_GQ = 2048, P_GK = 2304, P_GV = 2560, P_GG = 3072, P_GA = 3584, P_GB = 4608;
constexpr float C2 = 0.125f * 1.4426950408889634f;
constexpr float RMS_EPS = 1e-6f;

constexpr size_t MiB = 1u << 20;
constexpr size_t WS_PROJ = 0, WS_OA = 352 * MiB, WS_OB = 384 * MiB, WS_MERGED = 416 * MiB, WS_GFG = 480 * MiB, WS_RSTD = 482 * MiB, WS_KMEAN = 483 * MiB, WS_END = 484 * MiB;

typedef unsigned short bf16_t;
__device__ __forceinline__ float bf2f(bf16_t u) { return __uint_as_float(((unsigned)u) << 16); }
__device__ __forceinline__ bf16_t f2bf(float f) { unsigned u = __float_as_uint(f); return (bf16_t)((u + 0x7fffu + ((u >> 16) & 1u)) >> 16); }

__device__ __forceinline__ float wave_sum(float v) {
#pragma unroll
    for (int o = 1; o < 64; o <<= 1) v += __shfl_xor(v, o);
    return v;
}
__device__ __forceinline__ float wave_max(float v) {
#pragma unroll
    for (int o = 1; o < 64; o <<= 1) v = fmaxf(v, __shfl_xor(v, o));
    return v;
}

__device__ __forceinline__ void sincos_acc(float a, float& s, float& c) {
    const double ad = (double)a;
    const double q = __builtin_rint(ad * 0.63661977236758134308);
    const float r = (float)(ad - q * 1.57079632679489661923);
    const float r2 = r * r;
    float sp = r2 * (1.f / 362880.f) - (1.f / 5040.f); sp = sp * r2 + (1.f / 120.f); sp = sp * r2 - (1.f / 6.f); sp = sp * r2 * r + r;
    float cp = -r2 * (1.f / 3628800.f) + (1.f / 40320.f); cp = cp * r2 - (1.f / 720.f); cp = cp * r2 + (1.f / 24.f); cp = cp * r2 - 0.5f; cp = cp * r2 + 1.f;
    const int qi = ((int)q) & 3;
    s = (qi == 0) ? sp : (qi == 1) ? cp : (qi == 2) ? -sp : -cp;
    c = (qi == 0) ? cp : (qi == 1) ? -sp : (qi == 2) ? -cp : sp;
}

__global__ void __launch_bounds__(256) k_rstd(const float* __restrict__ x, float* __restrict__ rstd) {
    const int row = blockIdx.x * 4 + (threadIdx.x >> 6), lane = threadIdx.x & 63;
    const float4* xr = (const float4*)(x + (size_t)row * D_MODEL);
    float s = 0.f;
#pragma unroll
    for (int j = 0; j < 4; ++j) { const float4 v = xr[lane + 64 * j]; s += v.x * v.x + v.y * v.y + v.z * v.z + v.w * v.w; }
    s = wave_sum(s);
    if (lane == 0) rstd[row] = rsqrtf(s * (1.f / D_MODEL) + RMS_EPS);
}

__global__ void __launch_bounds__(256) k_inproj(const float* __restrict__ x, const float* __restrict__ rstd, const float* __restrict__ g,
                                                const float* __restrict__ w, const float* __restrict__ bmerge, bf16_t* __restrict__ proj, float* __restrict__ gfg) {
    __shared__ float As[16][64];
    __shared__ float Bs[16][64];
    __shared__ float Cs[64][65];
    const int tid = threadIdx.x, tx = tid & 15, ty = tid >> 4;
    const int row0 = blockIdx.y * 64, col0 = blockIdx.x * 64;
    float acc[4][4];
#pragma unroll
    for (int i = 0; i < 4; ++i)
#pragma unroll
        for (int j = 0; j < 4; ++j) acc[i][j] = 0.f;
    for (int k0 = 0; k0 < D_MODEL; k0 += 16) {
#pragma unroll
        for (int i = 0; i < 4; ++i) { const int idx = tid + 256 * i, r = idx >> 4, kk = idx & 15; As[kk][r] = x[(size_t)(row0 + r) * D_MODEL + k0 + kk] * rstd[row0 + r] * g[k0 + kk]; }
#pragma unroll
        for (int i = 0; i < 4; ++i) { const int idx = tid + 256 * i, kk = idx >> 6, c = idx & 63, col = col0 + c; Bs[kk][c] = col < N_IN ? w[(size_t)(k0 + kk) * N_IN + col] : 0.f; }
        __syncthreads();
#pragma unroll
        for (int kk = 0; kk < 16; ++kk) {
            float a[4], b[4];
#pragma unroll
            for (int i = 0; i < 4; ++i) { a[i] = As[kk][ty * 4 + i]; b[i] = Bs[kk][tx * 4 + i]; }
#pragma unroll
            for (int i = 0; i < 4; ++i)
#pragma unroll
                for (int j = 0; j < 4; ++j) acc[i][j] += a[i] * b[j];
        }
        __syncthreads();
    }
#pragma unroll
    for (int i = 0; i < 4; ++i)
#pragma unroll
        for (int j = 0; j < 4; ++j) Cs[ty * 4 + i][tx * 4 + j] = acc[i][j];
    __syncthreads();
    for (int e = 0; e < 16; ++e) {
        const int idx = tid + 256 * e, r = idx >> 6, c = idx & 63, col = col0 + c, row = row0 + r;
        if (col >= N_IN) continue;
        const float v = Cs[r][c];
        bf16_t* prow = proj + (size_t)row * NP;
        if (col < 1024) {
            const int hd = col & 63, f = hd & 31;
            const float partner = Cs[r][c ^ 32];
            const int pos = row & (SEQ - 1);
            const float invf = 1.0f / powf(10000.0f, (float)f * (1.0f / 32.0f));
            const float ang = (float)pos * invf;
            float sn, cs; sincos_acc(ang, sn, cs);
            float o = (hd < 32) ? (v * cs - partner * sn) : (partner * sn + v * cs);
            if (col < 512) o *= C2;
            prow[col] = f2bf(o);
        } else if (col < 1536) { prow[col] = f2bf(v);
        } else if (col < 2048) { prow[col] = f2bf(v / (1.f + expf(-v)));
        } else if (col < 2304) { prow[col] = f2bf(v * 0.125f);
        } else if (col < 3072) { prow[col] = f2bf(v);
        } else if (col < 3584) { prow[col] = f2bf(v / (1.f + expf(-v)));
        } else if (col < 3600) { gfg[(size_t)row * 16 + (col - 3584)] = v;
        } else if (col < 4624) { const int cc = col - 3600; prow[P_GA + cc] = f2bf(1.f / (1.f + expf(-(v + bmerge[cc]))));
        } else { const int cc = col - 4624; prow[P_GB + cc] = f2bf(1.f / (1.f + expf(-(v + bmerge[1024 + cc])))); }
    }
}

__global__ void __launch_bounds__(512) k_kmean(const bf16_t* __restrict__ proj, float* __restrict__ kmean) {
    const int bb = blockIdx.x, c = threadIdx.x;
    const bf16_t* p = proj + (size_t)bb * 256 * NP + P_MK + c;
    float s = 0.f;
    for (int r = 0; r < 256; ++r) s += bf2f(p[(size_t)r * NP]);
    kmean[(size_t)bb * 512 + c] = s * (1.f / 256.f);
}

__global__ void __launch_bounds__(256) k_moba(const bf16_t* __restrict__ proj, const float* __restrict__ kmean, bf16_t* __restrict__ oa) {
    __shared__ float qs[4][64];
    __shared__ float ps[4][1024];
    const int w = threadIdx.x >> 6, lane = threadIdx.x & 63;
    const int gid = blockIdx.x * 4 + w;
    const int row = gid >> 3, h = gid & 7;
    const int b = row >> 12, t = row & (SEQ - 1), own = t >> 8;
    qs[w][lane] = bf2f(proj[(size_t)row * NP + P_MQ + h * 64 + lane]);
    __syncthreads();
    float sc = -3.0e38f;
    if (lane < own) {
        const float* km = kmean + (size_t)(b * 16 + lane) * 512 + h * 64;
        float s = 0.f;
        for (int d = 0; d < 64; ++d) s += qs[w][d] * km[d];
        sc = s;
    }
    int s0 = -1, s1 = -1, s2 = -1;
    const int nv = own < 3 ? own : 3;
    for (int r = 0; r < 3; ++r) {
        float best = -3.0e38f; int bi = 0;
        for (int i = 0; i < 16; ++i) { const float v = __shfl(sc, i); if (v > best) { best = v; bi = i; } }
        if (r < nv) { if (r == 0) s0 = bi; else if (r == 1) s1 = bi; else s2 = bi; if (lane == bi) sc = -3.0e38f; }
    }
    int nkeys = 0; float mx = -3.0e38f;
    for (int s = 0; s < 4; ++s) {
        const int blk = (s == 0) ? s0 : (s == 1) ? s1 : (s == 2) ? s2 : own;
        if (blk < 0) continue;
        const int cnt = (blk == own) ? (t - own * 256 + 1) : 256;
        for (int k0 = 0; k0 < cnt; k0 += 64) {
            const int kk = k0 + lane;
            if (kk < cnt) {
                const bf16_t* kp = proj + (size_t)(b * SEQ + blk * 256 + kk) * NP + P_MK + h * 64;
                float dsum = 0.f;
                for (int d = 0; d < 64; ++d) dsum += qs[w][d] * bf2f(kp[d]);
                ps[w][nkeys + kk] = dsum; mx = fmaxf(mx, dsum);
            }
        }
        nkeys += cnt;
    }
    mx = wave_max(mx);
    __syncthreads();
    float l = 0.f;
    for (int k = lane; k < nkeys; k += 64) { const float p = exp2f(ps[w][k] - mx); ps[w][k] = p; l += p; }
    l = wave_sum(l);
    __syncthreads();
    float o = 0.f; int base = 0;
    for (int s = 0; s < 4; ++s) {
        const int blk = (s == 0) ? s0 : (s == 1) ? s1 : (s == 2) ? s2 : own;
        if (blk < 0) continue;
        const int cnt = (blk == own) ? (t - own * 256 + 1) : 256;
        const bf16_t* vp = proj + (size_t)(b * SEQ + blk * 256) * NP + P_MV + h * 64 + lane;
        for (int k = 0; k < cnt; ++k) o += ps[w][base + k] * bf2f(vp[(size_t)k * NP]);
        base += cnt;
    }
    o = o / l;
    const float gate = bf2f(proj[(size_t)row * NP + P_MG + h * 64 + lane]);
    oa[(size_t)row * 512 + h * 64 + lane] = f2bf(o * gate);
}

__global__ void __launch_bounds__(128) k_gla(const bf16_t* __restrict__ proj, const float* __restrict__ gfg, const float* __restrict__ wfg2, const float* __restrict__ bfg,
                                             const float* __restrict__ gnorm, bf16_t* __restrict__ ob) {
    __shared__ float sq[64], sk[64], sa[64];
    __shared__ float red[2];
    const int b = blockIdx.x >> 2, h = blockIdx.x & 3, j = threadIdx.x;
    float S[64];
#pragma unroll
    for (int k = 0; k < 64; ++k) S[k] = 0.f;
    float wcol[16]; float bias = 0.f;
#pragma unroll
    for (int r = 0; r < 16; ++r) wcol[r] = 0.f;
    if (j < 64) {
#pragma unroll
        for (int r = 0; r < 16; ++r) wcol[r] = wfg2[r * 256 + h * 64 + j];
        bias = bfg[h * 64 + j];
    }
    const float gn = gnorm[j];
    for (int t = 0; t < SEQ; ++t) {
        const size_t row = (size_t)b * SEQ + t;
        if (j < 64) {
            float z = bias;
#pragma unroll
            for (int r = 0; r < 16; ++r) z += gfg[row * 16 + r] * wcol[r];
            const float ls = fminf(z, 0.f) - log1pf(expf(-fabsf(z)));
            sa[j] = expf(ls * (1.f / 16.f));
            sq[j] = bf2f(proj[row * NP + P_GQ + h * 64 + j]);
            sk[j] = bf2f(proj[row * NP + P_GK + h * 64 + j]);
        }
        __syncthreads();
        const float v = bf2f(proj[row * NP + P_GV + h * 128 + j]);
        float o = 0.f;
#pragma unroll
        for (int k = 0; k < 64; ++k) { S[k] = sa[k] * S[k] + sk[k] * v; o += sq[k] * S[k]; }
        float ss = wave_sum(o * o);
        if ((j & 63) == 0) red[j >> 6] = ss;
        __syncthreads();
        ss = red[0] + red[1];
        const float rs = rsqrtf(ss * (1.f / 128.f) + RMS_EPS);
        const float gate = bf2f(proj[row * NP + P_GG + h * 128 + j]);
        ob[row * 512 + h * 128 + j] = f2bf(o * rs * gn * gate);
    }
}

__global__ void __launch_bounds__(256) k_merge(const bf16_t* __restrict__ oa, const bf16_t* __restrict__ obb, const float* __restrict__ wa, const float* __restrict__ wb,
                                               const bf16_t* __restrict__ proj, bf16_t* __restrict__ merged) {
    __shared__ float As[16][64];
    __shared__ float Bs[16][64];
    const int tid = threadIdx.x, tx = tid & 15, ty = tid >> 4;
    const int row0 = blockIdx.y * 64, col0 = blockIdx.x * 64;
    float res[4][4];
#pragma unroll
    for (int i = 0; i < 4; ++i)
#pragma unroll
        for (int j = 0; j < 4; ++j) res[i][j] = 0.f;
    for (int br = 0; br < 2; ++br) {
        const bf16_t* A = br ? obb : oa; const float* W = br ? wb : wa;
        float acc[4][4];
#pragma unroll
        for (int i = 0; i < 4; ++i)
#pragma unroll
            for (int j = 0; j < 4; ++j) acc[i][j] = 0.f;
        for (int k0 = 0; k0 < 512; k0 += 16) {
#pragma unroll
            for (int i = 0; i < 4; ++i) { const int idx = tid + 256 * i, r = idx >> 4, kk = idx & 15; As[kk][r] = bf2f(A[(size_t)(row0 + r) * 512 + k0 + kk]); }
#pragma unroll
            for (int i = 0; i < 4; ++i) { const int idx = tid + 256 * i, kk = idx >> 6, c = idx & 63; Bs[kk][c] = W[(size_t)(k0 + kk) * 1024 + col0 + c]; }
            __syncthreads();
#pragma unroll
            for (int kk = 0; kk < 16; ++kk) {
                float a[4], bq[4];
#pragma unroll
                for (int i = 0; i < 4; ++i) { a[i] = As[kk][ty * 4 + i]; bq[i] = Bs[kk][tx * 4 + i]; }
#pragma unroll
                for (int i = 0; i < 4; ++i)
#pragma unroll
                    for (int j = 0; j < 4; ++j) acc[i][j] += a[i] * bq[j];
            }
            __syncthreads();
        }
        const int pc = br ? P_GB : P_GA;
#pragma unroll
        for (int i = 0; i < 4; ++i)
#pragma unroll
            for (int j = 0; j < 4; ++j) {
                const int row = row0 + ty * 4 + i, col = col0 + tx * 4 + j;
                res[i][j] += bf2f(proj[(size_t)row * NP + pc + col]) * acc[i][j];
            }
    }
#pragma unroll
    for (int i = 0; i < 4; ++i)
#pragma unroll
        for (int j = 0; j < 4; ++j) merged[(size_t)(row0 + ty * 4 + i) * 1024 + col0 + tx * 4 + j] = f2bf(res[i][j]);
}

__global__ void __launch_bounds__(256) k_out(const bf16_t* __restrict__ merged, const float* __restrict__ wout, const float* __restrict__ x, float* __restrict__ out) {
    __shared__ float As[16][64];
    __shared__ float Bs[16][64];
    const int tid = threadIdx.x, tx = tid & 15, ty = tid >> 4;
    const int row0 = blockIdx.y * 64, col0 = blockIdx.x * 64;
    float acc[4][4];
#pragma unroll
    for (int i = 0; i < 4; ++i)
#pragma unroll
        for (int j = 0; j < 4; ++j) acc[i][j] = 0.f;
    for (int k0 = 0; k0 < 1024; k0 += 16) {
#pragma unroll
        for (int i = 0; i < 4; ++i) { const int idx = tid + 256 * i, r = idx >> 4, kk = idx & 15; As[kk][r] = bf2f(merged[(size_t)(row0 + r) * 1024 + k0 + kk]); }
#pragma unroll
        for (int i = 0; i < 4; ++i) { const int idx = tid + 256 * i, kk = idx >> 6, c = idx & 63; Bs[kk][c] = wout[(size_t)(k0 + kk) * 1024 + col0 + c]; }
        __syncthreads();
#pragma unroll
        for (int kk = 0; kk < 16; ++kk) {
            float a[4], bq[4];
#pragma unroll
            for (int i = 0; i < 4; ++i) { a[i] = As[kk][ty * 4 + i]; bq[i] = Bs[kk][tx * 4 + i]; }
#pragma unroll
            for (int i = 0; i < 4; ++i)
#pragma unroll
                for (int j = 0; j < 4; ++j) acc[i][j] += a[i] * bq[j];
        }
        __syncthreads();
    }
#pragma unroll
    for (int i = 0; i < 4; ++i)
#pragma unroll
        for (int j = 0; j < 4; ++j) {
            const size_t o = (size_t)(row0 + ty * 4 + i) * 1024 + col0 + tx * 4 + j;
            out[o] = x[o] + acc[i][j];
        }
}

__global__ void __launch_bounds__(256) k_final(float* __restrict__ out, const float* __restrict__ g) {
    const int row = blockIdx.x * 4 + (threadIdx.x >> 6), lane = threadIdx.x & 63;
    float4* xr = (float4*)(out + (size_t)row * D_MODEL);
    const float4* gr = (const float4*)g;
    float4 v[4]; float s = 0.f;
#pragma unroll
    for (int j = 0; j < 4; ++j) { v[j] = xr[lane + 64 * j]; s += v[j].x * v[j].x + v[j].y * v[j].y + v[j].z * v[j].z + v[j].w * v[j].w; }
    s = wave_sum(s);
    const float rs = rsqrtf(s * (1.f / D_MODEL) + RMS_EPS);
#pragma unroll
    for (int j = 0; j < 4; ++j) { const float4 gg = gr[lane + 64 * j]; float4 o; o.x = v[j].x * rs * gg.x; o.y = v[j].y * rs * gg.y; o.z = v[j].z * rs * gg.z; o.w = v[j].w * rs * gg.w; xr[lane + 64 * j] = o; }
}

extern "C" void kernel_launch(void* const* d_in, const int* in_sizes, int n_in, void* d_out, int out_size, void* d_ws, size_t ws_size, hipStream_t stream) {
    if (n_in != 11 || in_sizes[0] != M * D_MODEL || out_size != M * D_MODEL || ws_size < WS_END) {
        fprintf(stderr, "kernel_launch: unexpected shapes n_in %d in0 %d out %d ws %zu\n", n_in, n_in > 0 ? in_sizes[0] : -1, out_size, ws_size);
        return;
    }
    const float* x = (const float*)d_in[0]; const float* norm_in_g = (const float*)d_in[1]; const float* w_in = (const float*)d_in[2];
    const float* b_merge = (const float*)d_in[3]; const float* w_fg2 = (const float*)d_in[4]; const float* b_fg = (const float*)d_in[5];
    const float* gla_norm_g = (const float*)d_in[6]; const float* w_proj_a = (const float*)d_in[7]; const float* w_proj_b = (const float*)d_in[8];
    const float* w_out = (const float*)d_in[9]; const float* norm_f_g = (const float*)d_in[10];
    unsigned char* ws = (unsigned char*)d_ws;
    bf16_t* proj = (bf16_t*)(ws + WS_PROJ); bf16_t* oa = (bf16_t*)(ws + WS_OA); bf16_t* ob = (bf16_t*)(ws + WS_OB); bf16_t* merged = (bf16_t*)(ws + WS_MERGED);
    float* gfg = (float*)(ws + WS_GFG); float* rstd = (float*)(ws + WS_RSTD); float* kmean = (float*)(ws + WS_KMEAN);
    float* out = (float*)d_out;
    hipLaunchKernelGGL(k_rstd, dim3(M / 4), dim3(256), 0, stream, x, rstd);
    hipLaunchKernelGGL(k_inproj, dim3((N_IN + 63) / 64, M / 64), dim3(256), 0, stream, x, rstd, norm_in_g, w_in, b_merge, proj, gfg);
    hipLaunchKernelGGL(k_kmean, dim3(BATCH * NBLK), dim3(512), 0, stream, proj, kmean);
    hipLaunchKernelGGL(k_moba, dim3(M * 8 / 4), dim3(256), 0, stream, proj, kmean, oa);
    hipLaunchKernelGGL(k_gla, dim3(BATCH * 4), dim3(128), 0, stream, proj, gfg, w_fg2, b_fg, gla_norm_g, ob);
    hipLaunchKernelGGL(k_merge, dim3(1024 / 64, M / 64), dim3(256), 0, stream, oa, ob, w_proj_a, w_proj_b, proj, merged);
    hipLaunchKernelGGL(k_out, dim3(1024 / 64, M / 64), dim3(256), 0, stream, merged, w_out, x, out);
    hipLaunchKernelGGL(k_final, dim3(M / 4), dim3(256), 0, stream, out, norm_f_g);
}
```

```cpp
#include <hip/hip_runtime.h>
#include <hip/hip_bf16.h>
#include <cstdio>
#include <cstdint>

constexpr int D_MODEL = 1024, BATCH = 8, SEQ = 4096, M = BATCH * SEQ;
constexpr int N_IN = 5648, NBLK = 16;
constexpr int NP = 5632;
constexpr int P_MQ = 0, P_MK = 512, P_MV = 1024, P_MG = 1536, P_GQ = 2048, P_GK = 2304, P_GV = 2560, P_GG = 3072, P_GA = 3584, P_GB = 4608;
constexpr int C_FG = 3584;
constexpr float C2 = 0.125f * 1.4426950408889634f;
constexpr float RMS_EPS = 1e-6f;


namespace pg8 {
#define PG8_LAS __attribute__((address_space(3)))
typedef unsigned short bf16_t;
typedef short bf16x8 __attribute__((ext_vector_type(8)));
typedef float f32x4 __attribute__((ext_vector_type(4)));
typedef unsigned u32x4 __attribute__((ext_vector_type(4)));
constexpr int BM = 256, BK = 64, HALF = 128, HTB = HALF * BK * 2  , STAGE_BYTES = 8 * HTB, NXCD = 8, WGM = 8;

__host__ __device__ __forceinline__ int lds_byte(int r, int c) { const int st = (r >> 4) * 2 + (c >> 5), rr = r & 15, cc = c & 31, ob = rr * 64 + cc * 2; return st * 1024 + (ob ^ (((ob >> 9) & 1) << 5)); }
__host__ __device__ __forceinline__ void stage_rc(int b, int& R, int& C) { const int st = b / 1024, sb = b % 1024, swz = sb ^ (((sb >> 9) & 1) << 5); R = (st >> 1) * 16 + swz / 64; C = (st & 1) * 32 + (swz % 64) / 2; }
__host__ __device__ __forceinline__ int perm32(int rho) { const int n = rho >> 4, i = rho & 15; return 8 * (i >> 2) + 4 * n + (i & 3); }

struct Unit { int pm, pn; };
struct Gemm { const bf16_t* A; const bf16_t* Bt; int M, N, K; };

struct StaticOrder {
    int nM, nN, nwg, G, c;
    __host__ __device__ void init(int M, int N, int G_, int c_) { nM = M / BM; nN = N / BM; nwg = nM * nN; G = G_; c = c_; }
    __host__ __device__ bool next(int i, Unit& u) const {
        const long L = (long)i * G + c; if (L >= nwg) return false;
        int wgid = (int)L; { const int q = nwg / NXCD, r = nwg % NXCD, xcd = wgid % NXCD, off = wgid / NXCD; wgid = (xcd < r ? xcd * (q + 1) : r * (q + 1) + (xcd - r) * q) + off; }
        const int nig = WGM * nN, gid = wgid / nig, fm = gid * WGM, gsz = (nM - fm) < WGM ? (nM - fm) : WGM;
        u.pm = fm + ((wgid % nig) % gsz); u.pn = (wgid % nig) / gsz; return true;
    }
    __device__ __forceinline__ void a_ready(const Unit&) const {}
    __device__ __forceinline__ void done(const Unit&) const {}
};
__device__ __forceinline__ unsigned cvt_pk_bf16(float lo, float hi) { unsigned r; asm volatile("v_cvt_pk_bf16_f32 %0, %1, %2" : "=v"(r) : "v"(lo), "v"(hi)); return r; }
typedef float f32x2 __attribute__((ext_vector_type(2)));
template <class Epi, class Sched, bool ALIGN_EPI = false, bool SP2 = false>
__device__ __forceinline__ void gemm_phase(PG8_LAS unsigned char* lds, const Gemm g, const Sched& S, const Epi& E) {
    const int tid = threadIdx.x, wid = __builtin_amdgcn_readfirstlane(tid >> 6), lane = tid & 63, wr = wid >> 2, wc = wid & 3, fr = lane & 15, fq = lane >> 4;
    const int K = g.K, nt = K / BK;
    unsigned voffA[2], voffB[2];
#pragma unroll
    for (int i = 0; i < 2; ++i) { int R, C; stage_rc(tid * 16 + i * 8192, R, C); const int Rb = Epi::PERM ? ((R & ~31) + perm32(R & 31)) : R;
        voffA[i] = (unsigned)(R * K + C) * 2u; voffB[i] = (unsigned)(Rb * K + C) * 2u; }
    const size_t kstep = (size_t)(BK * 2);
    const size_t hstep = (size_t)HALF * K * 2;
    const size_t tstep = 2 * hstep;
    const unsigned ldsw = (unsigned)wid * 1024u;
    const int aoff = lds_byte(wr * 64 + fr, fq * 8), boff = lds_byte(wc * 32 + fr, fq * 8);
#define PG8_SA(b, h) (((b) * 2 + (h)) * HTB)
#define PG8_SB(b, h) ((4 + (b) * 2 + (h)) * HTB)
#define PG8_STAGE(bufoff, gbase, voff) do { _Pragma("unroll") for (int _i = 0; _i < 2; ++_i) \
        __builtin_amdgcn_global_load_lds((const unsigned*)((const char*)(gbase) + (voff)[_i]), (PG8_LAS unsigned*)(lds + (bufoff) + ldsw + _i * 8192), 16, 0, 0); } while (0)
#define PG8_LDA(dst, b, h) do { _Pragma("unroll") for (int m = 0; m < 4; ++m) _Pragma("unroll") for (int k = 0; k < 2; ++k) dst[m][k] = *(const PG8_LAS bf16x8*)(lds + PG8_SA(b, h) + aoff + m * 2048 + k * 1024); } while (0)
#define PG8_LDB(dst, b, h) do { _Pragma("unroll") for (int n = 0; n < 2; ++n) _Pragma("unroll") for (int k = 0; k < 2; ++k) dst[n][k] = *(const PG8_LAS bf16x8*)(lds + PG8_SB(b, h) + boff + n * 2048 + k * 1024); } while (0)
#define PG8_MMA(ai, bj, At, Bt) do { __builtin_amdgcn_s_setprio(1); _Pragma("unroll") for (int m = 0; m < 4; ++m) _Pragma("unroll") for (int n = 0; n < 2; ++n) _Pragma("unroll") for (int k = 0; k < 2; ++k) \
        acc[ai][bj][m][n] = __builtin_amdgcn_mfma_f32_16x16x32_bf16(Bt[n][k], At[m][k], acc[ai][bj][m][n], 0, 0, 0); __builtin_amdgcn_s_setprio(0); } while (0)
#define PG8_WAIT_V(n) asm volatile("s_waitcnt vmcnt(" #n ")" ::: "memory")
#define PG8_WAIT_L(n) asm volatile("s_waitcnt lgkmcnt(" #n ")" ::: "memory")
#define PG8_BAR __builtin_amdgcn_s_barrier()
#define PG8_SCHED __builtin_amdgcn_sched_barrier(0)
    Unit cur, nxt; int ui = 0;
    if (!S.next(0, cur)) return;
    f32x4 acc[2][2][4][2];
#pragma unroll
    for (int a = 0; a < 2; ++a)
#pragma unroll
        for (int b = 0; b < 2; ++b)
#pragma unroll
            for (int m = 0; m < 4; ++m)
#pragma unroll
                for (int n = 0; n < 2; ++n) acc[a][b][m][n] = (f32x4){0.f, 0.f, 0.f, 0.f};
    bf16x8 At[4][2], B0[2][2], B1[2][2];
    const char* cA = (const char*)g.A + (size_t)cur.pm * tstep; const char* cB = (const char*)g.Bt + (size_t)cur.pn * tstep;
    S.a_ready(cur);
    if constexpr (SP2) {
        PG8_STAGE(PG8_SB(0, 0), cB, voffB); PG8_STAGE(PG8_SB(0, 1), cB + hstep, voffB); PG8_STAGE(PG8_SA(0, 0), cA, voffA); PG8_STAGE(PG8_SA(0, 1), cA + hstep, voffA);
        if (wr == 1) PG8_BAR;
        PG8_WAIT_V(2); PG8_BAR;
        PG8_STAGE(PG8_SB(1, 0), cB + kstep, voffB); PG8_STAGE(PG8_SA(1, 0), cA + kstep, voffA); PG8_STAGE(PG8_SB(1, 1), cB + hstep + kstep, voffB);
        PG8_WAIT_V(6); PG8_BAR;
    } else {
        PG8_STAGE(PG8_SB(0, 0), cB, voffB); PG8_STAGE(PG8_SA(0, 0), cA, voffA); PG8_STAGE(PG8_SB(0, 1), cB + hstep, voffB); PG8_STAGE(PG8_SA(0, 1), cA + hstep, voffA);
        if (wr == 1) PG8_BAR;
        PG8_WAIT_V(4); PG8_BAR;
        PG8_STAGE(PG8_SB(1, 0), cB + kstep, voffB); PG8_STAGE(PG8_SA(1, 0), cA + kstep, voffA); PG8_STAGE(PG8_SB(1, 1), cB + hstep + kstep, voffB);
        PG8_WAIT_V(6); PG8_BAR;
    }
    for (;;) {
        const bool has_next = S.next(ui + 1, nxt);
        const char* nA = has_next ? (const char*)g.A + (size_t)nxt.pm * tstep : cA; const char* nB = has_next ? (const char*)g.Bt + (size_t)nxt.pn * tstep : cB;
        for (int t = 0; t < nt; t += 2) {
            const bool last = (t == nt - 2);
            const char* a1 = cA + (size_t)(t + 1) * kstep;
            const char* a2 = last ? nA : cA + (size_t)(t + 2) * kstep; const char* b2 = last ? nB : cB + (size_t)(t + 2) * kstep;
            const char* a3 = a2 + kstep; const char* b3 = b2 + kstep;
            if (last && has_next) S.a_ready(nxt);
            if constexpr (SP2) {
            PG8_LDB(B0, 0, 0); PG8_LDB(B1, 0, 1); PG8_SCHED; PG8_LDA(At, 0, 0); PG8_STAGE(PG8_SA(1, 1), a1 + hstep, voffA);
            PG8_WAIT_V(8); PG8_WAIT_L(0); PG8_BAR; PG8_MMA(0, 0, At, B0); PG8_MMA(0, 1, At, B1); PG8_BAR; PG8_SCHED;
            PG8_LDA(At, 0, 1); PG8_STAGE(PG8_SB(0, 0), b2, voffB); PG8_STAGE(PG8_SB(0, 1), b2 + hstep, voffB); PG8_STAGE(PG8_SA(0, 0), a2, voffA);
            PG8_WAIT_V(8); PG8_WAIT_L(0); PG8_BAR; PG8_MMA(1, 0, At, B0); PG8_MMA(1, 1, At, B1); PG8_BAR; PG8_SCHED;
            PG8_LDB(B0, 1, 0); PG8_LDB(B1, 1, 1); PG8_SCHED; PG8_LDA(At, 1, 0); PG8_STAGE(PG8_SA(0, 1), a2 + hstep, voffA);
            PG8_WAIT_V(8); PG8_WAIT_L(0); PG8_BAR; PG8_MMA(0, 0, At, B0); PG8_MMA(0, 1, At, B1); PG8_BAR; PG8_SCHED;
            PG8_LDA(At, 1, 1); PG8_STAGE(PG8_SB(1, 0), b3, voffB); PG8_STAGE(PG8_SB(1, 1), b3 + hstep, voffB); PG8_STAGE(PG8_SA(1, 0), a3, voffA);
            PG8_WAIT_V(8); PG8_WAIT_L(0); PG8_BAR; PG8_MMA(1, 0, At, B0); PG8_MMA(1, 1, At, B1); PG8_BAR; PG8_SCHED;
            } else {
            PG8_LDB(B0, 0, 0); PG8_SCHED; PG8_LDA(At, 0, 0); PG8_STAGE(PG8_SA(1, 1), a1 + hstep, voffA);
            PG8_WAIT_L(8); PG8_BAR; PG8_WAIT_L(0); PG8_MMA(0, 0, At, B0); PG8_BAR; PG8_SCHED;
            PG8_LDB(B1, 0, 1); PG8_STAGE(PG8_SB(0, 0), b2, voffB);
            PG8_BAR; PG8_WAIT_L(0); PG8_MMA(0, 1, At, B1); PG8_BAR;
            PG8_LDA(At, 0, 1); PG8_STAGE(PG8_SA(0, 0), a2, voffA);
            PG8_BAR; PG8_WAIT_L(0); PG8_MMA(1, 0, At, B0); PG8_BAR; PG8_SCHED;
            PG8_STAGE(PG8_SB(0, 1), b2 + hstep, voffB);
            PG8_WAIT_V(6); PG8_BAR; PG8_MMA(1, 1, At, B1); PG8_BAR;
            PG8_LDB(B0, 1, 0); PG8_SCHED; PG8_LDA(At, 1, 0); PG8_STAGE(PG8_SA(0, 1), a2 + hstep, voffA);
            PG8_WAIT_L(8); PG8_BAR; PG8_WAIT_L(0); PG8_MMA(0, 0, At, B0); PG8_BAR; PG8_SCHED;
            PG8_LDB(B1, 1, 1); PG8_STAGE(PG8_SB(1, 0), b3, voffB);
            PG8_BAR; PG8_WAIT_L(0); PG8_MMA(0, 1, At, B1); PG8_BAR;
            PG8_LDA(At, 1, 1); PG8_STAGE(PG8_SA(1, 0), a3, voffA);
            PG8_BAR; PG8_WAIT_L(0); PG8_MMA(1, 0, At, B0); PG8_BAR; PG8_SCHED;
            PG8_STAGE(PG8_SB(1, 1), b3 + hstep, voffB);
            PG8_WAIT_V(6); PG8_BAR; PG8_MMA(1, 1, At, B1); PG8_BAR;
            }
        }
        if constexpr (ALIGN_EPI) { if (wr == 0) PG8_BAR; }
        if constexpr (!Epi::AFTER_DRAIN) { E(acc, cur, wr, wc, fr, fq); S.done(cur); }
        if (!has_next) break;
#pragma unroll
        for (int a = 0; a < 2; ++a)
#pragma unroll
            for (int b = 0; b < 2; ++b)
#pragma unroll
                for (int m = 0; m < 4; ++m)
#pragma unroll
                    for (int n = 0; n < 2; ++n) acc[a][b][m][n] = (f32x4){0.f, 0.f, 0.f, 0.f};
        cur = nxt; cA = nA; cB = nB; ++ui;
        if constexpr (ALIGN_EPI) { if (wr == 1) PG8_BAR; }
    }
    PG8_WAIT_V(0);
    if constexpr (!ALIGN_EPI) { if (wr == 0) PG8_BAR; }
    PG8_BAR;
    if constexpr (Epi::AFTER_DRAIN) { E.fused(acc, cur, wr, wc, fr, fq, lds, wid, lane); S.done(cur); }
#undef PG8_SA
#undef PG8_SB
#undef PG8_STAGE
#undef PG8_LDA
#undef PG8_LDB
#undef PG8_MMA
#undef PG8_WAIT_V
#undef PG8_WAIT_L
#undef PG8_BAR
#undef PG8_SCHED
}
}

#define GAS __attribute__((address_space(1)))
#define LAS __attribute__((address_space(3)))
typedef unsigned short bf16;
typedef unsigned v4u __attribute__((ext_vector_type(4)));
typedef float f32x4 __attribute__((ext_vector_type(4)));
typedef short bf16x8 __attribute__((ext_vector_type(8)));
typedef GAS unsigned gu32;
typedef GAS unsigned long long gu64;
#define RLX_AGENT __ATOMIC_RELAXED, __HIP_MEMORY_SCOPE_AGENT
#define LDS_WAIT() asm volatile("s_waitcnt lgkmcnt(0)" ::: "memory")
#define VM_WAIT() asm volatile("s_waitcnt vmcnt(0)" ::: "memory")
__device__ __forceinline__ unsigned long long rt() { return __builtin_amdgcn_s_memrealtime(); }
__device__ __forceinline__ unsigned f2bf(float f) { unsigned u = __builtin_bit_cast(unsigned, f); return (u + 0x7fffu + ((u >> 16) & 1u)) >> 16; }
__device__ __forceinline__ unsigned pk2(float lo, float hi) { return f2bf(lo) | (f2bf(hi) << 16); }

#define XB_TMO      128
#define XB_XCNT(j)  (256  + 64 * (j))
#define XB_XSUB(j)  (1280 + 64 * (j))
#define XB_XGEN(j)  (2304 + 64 * (j))
#define XB_TOP      3328
#define XB_TOPGEN   3392
#define XCD_BAR_WORDS 3456
#define XB_SPIN_CAP (1u << 18)

__device__ __forceinline__ unsigned xb_ld(unsigned* p)              { return __hip_atomic_load(p, __ATOMIC_RELAXED, __HIP_MEMORY_SCOPE_AGENT); }
__device__ __forceinline__ unsigned xb_add(unsigned* p, unsigned v) { return __hip_atomic_fetch_add(p, v, __ATOMIC_RELAXED, __HIP_MEMORY_SCOPE_AGENT); }
__device__ __forceinline__ unsigned xb_xcc_id() { return (unsigned)__builtin_amdgcn_s_getreg((3 << 11) | 20) & 0xFu; }
#define XB_SPIN(cond, bar) do { unsigned _sp = 0; while (cond) { __builtin_amdgcn_s_sleep(1); \
    if ((++_sp & 255u) == 0u) { if (xb_ld(&(bar)[XB_TMO])) break; if (_sp > XB_SPIN_CAP) { atomicAdd(&(bar)[XB_TMO], 1u); break; } } } } while (0)

struct XcdBarrier {
    unsigned* bar; unsigned x;
    volatile LAS unsigned* st;
};

__device__ __forceinline__ XcdBarrier xcd_barrier_post(unsigned* bar, volatile LAS unsigned* st) {
    XcdBarrier b; b.bar = bar; b.x = xb_xcc_id(); b.st = st;
    if (threadIdx.x == 0) (void)xb_add(&bar[XB_XCNT(b.x)], 1u);
    return b;
}
__device__ __forceinline__ void xcd_barrier_complete(unsigned* bar, unsigned x, unsigned& nloc, unsigned& nx) {
    const unsigned G = gridDim.x * gridDim.y * gridDim.z;
    unsigned sum, cnt, mine, sp = 0u;
    for (;;) {
        sum = 0u; cnt = 0u; mine = 0u;
#pragma unroll
        for (unsigned j = 0; j < 16; ++j) { const unsigned c = xb_ld(&bar[XB_XCNT(j)]); sum += c; cnt += (c > 0u) ? 1u : 0u; mine = (j == x) ? c : mine; }
        if (sum == G) break;
        __builtin_amdgcn_s_sleep(1);
        if ((++sp & 255u) == 0u) { if (xb_ld(&bar[XB_TMO])) break; if (sp > XB_SPIN_CAP) { atomicAdd(&bar[XB_TMO], 1u); break; } }
    }
    nloc = mine > 0u ? mine : 1u; nx = cnt > 0u ? cnt : 1u;
}

__device__ __forceinline__ void xcd_barrier(const XcdBarrier& b) {
    asm volatile("s_waitcnt vmcnt(0)" ::: "memory");
    __syncthreads();
    if (threadIdx.x == 0) {
        unsigned* bar = b.bar;
        __builtin_amdgcn_s_waitcnt(0);
        unsigned nloc = b.st[0], nx = b.st[1];
        if (nloc == 0u) { xcd_barrier_complete(bar, b.x, nloc, nx); b.st[0] = nloc; b.st[1] = nx; }
        const unsigned old = xb_add(&bar[XB_XSUB(b.x)], 1u);
        const unsigned gen = old / nloc;
        if (old + 1u == (gen + 1u) * nloc) {
            __builtin_amdgcn_fence(__ATOMIC_RELEASE, "agent");
            asm volatile("s_waitcnt vmcnt(0)" ::: "memory");
            const unsigned og = xb_add(&bar[XB_TOP], 1u);
            const unsigned tg = og / nx;
            if (og + 1u == (tg + 1u) * nx) xb_add(&bar[XB_TOPGEN], 1u);
            else XB_SPIN(xb_ld(&bar[XB_TOPGEN]) == tg, bar);
            __builtin_amdgcn_fence(__ATOMIC_ACQUIRE, "agent");
            xb_add(&bar[XB_XGEN(b.x)], 1u);
            asm volatile("s_waitcnt vmcnt(0)" ::: "memory");
        } else {
            XB_SPIN(xb_ld(&bar[XB_XGEN(b.x)]) == gen, bar);
            __builtin_amdgcn_fence(__ATOMIC_ACQUIRE, "agent");
            asm volatile("s_waitcnt vmcnt(0)" ::: "memory");
        }
    }
    __syncthreads();
}

typedef unsigned short bf16_t;
typedef unsigned u32x4 __attribute__((ext_vector_type(4)));
typedef float f32x2v_t __attribute__((ext_vector_type(2))); typedef __bf16 bf16x2v_t __attribute__((ext_vector_type(2)));
__device__ __forceinline__ unsigned cvt_pk_bf16(float lo, float hi) { f32x2v_t v = {lo, hi}; bf16x2v_t b = __builtin_convertvector(v, bf16x2v_t); return __builtin_bit_cast(unsigned, b); }

__device__ __forceinline__ float fast_sigmoid(float z) { return __builtin_amdgcn_rcpf(1.f + __expf(-z)); }
__device__ __forceinline__ f32x4 silu4(f32x4 v) { f32x4 o; o[0] = v[0] * fast_sigmoid(v[0]); o[1] = v[1] * fast_sigmoid(v[1]); o[2] = v[2] * fast_sigmoid(v[2]); o[3] = v[3] * fast_sigmoid(v[3]); return o; }
__device__ __forceinline__ f32x4 sigm4(f32x4 v) { f32x4 o; o[0] = fast_sigmoid(v[0]); o[1] = fast_sigmoid(v[1]); o[2] = fast_sigmoid(v[2]); o[3] = fast_sigmoid(v[3]); return o; }

struct EpiInproj {
    static constexpr bool PERM = true, AFTER_DRAIN = false;
    bf16_t* proj; const float* cosT; const float* sinT; const float* bmerge; float* kpart;
    __device__ __forceinline__ void operator()(const f32x4 (&acc)[2][2][4][2], const pg8::Unit& u, int wr, int wc, int fr, int fq) const {
        const int pn = u.pn;
        const int row0 = u.pm * 256 + wr * 64 + fr;
        const int colw = wc * 32 + 8 * fq;
        bf16_t* base = proj + (size_t)row0 * NP + pn * 256 + colw;
        if (pn < 4) {
            const int fi0 = 16 * (wc & 1) + 4 * fq;
            f32x4 cs[2][2];
#pragma unroll
            for (int a = 0; a < 2; ++a)
#pragma unroll
                for (int b = 0; b < 2; ++b) cs[a][b] = (f32x4){0.f, 0.f, 0.f, 0.f};
#pragma unroll
            for (int ai = 0; ai < 2; ++ai)
#pragma unroll
                for (int m = 0; m < 4; ++m) {
                    const int row = row0 + ai * 128 + m * 16, pos = row & (SEQ - 1);
                    const f32x4 c4 = *(const f32x4*)(cosT + pos * 32 + fi0), s4 = *(const f32x4*)(sinT + pos * 32 + fi0);
                    bf16_t* rowp = base + (size_t)(ai * 128 + m * 16) * NP;
#pragma unroll
                    for (int bj = 0; bj < 2; ++bj) {
                        const f32x4 v0 = acc[ai][bj][m][0], v1 = acc[ai][bj][m][1];
                        f32x4 o1 = v0 * c4 - v1 * s4, o2 = v0 * s4 + v1 * c4;
                        if (pn < 2) { o1 = o1 * C2; o2 = o2 * C2; } else { cs[bj][0] += o1; cs[bj][1] += o2; }
                        u32x4 w; w.x = cvt_pk_bf16(o1[0], o1[1]); w.y = cvt_pk_bf16(o1[2], o1[3]); w.z = cvt_pk_bf16(o2[0], o2[1]); w.w = cvt_pk_bf16(o2[2], o2[3]);
                        *(u32x4*)(rowp + bj * 128) = w;
                    }
                }
            if (pn >= 2) {
#pragma unroll
                for (int bj = 0; bj < 2; ++bj)
#pragma unroll
                    for (int n = 0; n < 2; ++n)
#pragma unroll
                        for (int i = 0; i < 4; ++i) {
                            float s = cs[bj][n][i];
                            s += __shfl_xor(s, 1); s += __shfl_xor(s, 2); s += __shfl_xor(s, 4); s += __shfl_xor(s, 8);
                            cs[bj][n][i] = s;
                        }
                if (fr == 0) {
                    float* kp = kpart + (size_t)(u.pm * 2 + wr) * 512 + (pn - 2) * 256 + colw;
#pragma unroll
                    for (int bj = 0; bj < 2; ++bj) { *(f32x4*)(kp + bj * 128) = cs[bj][0]; *(f32x4*)(kp + bj * 128 + 4) = cs[bj][1]; }
                }
            }
        } else {
            const int mode = (pn < 6) ? 0 : (pn < 8) ? 1 : (pn == 8) ? 2 : (pn < 12) ? 0 : (pn < 14) ? 1 : 3;
            f32x4 bv[2][2];
#pragma unroll
            for (int bj = 0; bj < 2; ++bj)
#pragma unroll
                for (int n = 0; n < 2; ++n) bv[bj][n] = (mode == 3) ? *(const f32x4*)(bmerge + (pn * 256 + bj * 128 + colw + 4 * n - P_GA)) : (f32x4){0.f, 0.f, 0.f, 0.f};
#pragma unroll
            for (int ai = 0; ai < 2; ++ai)
#pragma unroll
                for (int m = 0; m < 4; ++m) {
                    bf16_t* rowp = base + (size_t)(ai * 128 + m * 16) * NP;
#pragma unroll
                    for (int bj = 0; bj < 2; ++bj) {
                        f32x4 v0 = acc[ai][bj][m][0], v1 = acc[ai][bj][m][1];
                        if (mode == 1) { v0 = silu4(v0); v1 = silu4(v1); }
                        else if (mode == 2) { v0 = v0 * 0.125f; v1 = v1 * 0.125f; }
                        else if (mode == 3) { v0 = sigm4(v0 + bv[bj][0]); v1 = sigm4(v1 + bv[bj][1]); }
                        u32x4 w; w.x = cvt_pk_bf16(v0[0], v0[1]); w.y = cvt_pk_bf16(v0[2], v0[3]); w.z = cvt_pk_bf16(v1[0], v1[1]); w.w = cvt_pk_bf16(v1[2], v1[3]);
                        *(u32x4*)(rowp + bj * 128) = w;
                    }
                }
        }
    }
};


__device__ __forceinline__ void unpack8(const u32x4 w, f32x4& lo, f32x4& hi) {
    lo[0] = __uint_as_float(w.x << 16); lo[1] = __uint_as_float(w.x & 0xffff0000u); lo[2] = __uint_as_float(w.y << 16); lo[3] = __uint_as_float(w.y & 0xffff0000u);
    hi[0] = __uint_as_float(w.z << 16); hi[1] = __uint_as_float(w.z & 0xffff0000u); hi[2] = __uint_as_float(w.w << 16); hi[3] = __uint_as_float(w.w & 0xffff0000u);
}
template <bool SECOND> struct EpiMerge {
    static constexpr bool PERM = true, AFTER_DRAIN = false;
    const bf16_t* proj; bf16_t* merged;
    __device__ __forceinline__ void operator()(const f32x4 (&acc)[2][2][4][2], const pg8::Unit& u, int wr, int wc, int fr, int fq) const {
        const int row0 = u.pm * 256 + wr * 64 + fr, col0 = u.pn * 256 + wc * 32 + 8 * fq;
#pragma unroll
        for (int ai = 0; ai < 2; ++ai)
#pragma unroll
            for (int m = 0; m < 4; ++m) {
                const size_t row = (size_t)(row0 + ai * 128 + m * 16);
#pragma unroll
                for (int bj = 0; bj < 2; ++bj) {
                    const int col = col0 + bj * 128;
                    f32x4 g0, g1; unpack8(*(const u32x4*)(proj + row * NP + (SECOND ? P_GB : P_GA) + col), g0, g1);
                    f32x4 v0 = acc[ai][bj][m][0] * g0, v1 = acc[ai][bj][m][1] * g1;
                    bf16_t* mp = merged + row * 1024 + col;
                    if (SECOND) { f32x4 t0, t1; unpack8(*(const u32x4*)mp, t0, t1); v0 += t0; v1 += t1; }
                    u32x4 w; w.x = cvt_pk_bf16(v0[0], v0[1]); w.y = cvt_pk_bf16(v0[2], v0[3]); w.z = cvt_pk_bf16(v1[0], v1[1]); w.w = cvt_pk_bf16(v1[2], v1[3]);
                    *(u32x4*)mp = w;
                }
            }
    }
};
struct EpiOut {
    static constexpr bool PERM = true, AFTER_DRAIN = false;
    const float* x; float* out; float* rowss;
    __device__ __forceinline__ void operator()(const f32x4 (&acc)[2][2][4][2], const pg8::Unit& u, int wr, int wc, int fr, int fq) const {
        const int row0 = u.pm * 256 + wr * 64 + fr, col0 = u.pn * 256 + wc * 32 + 8 * fq;
#pragma unroll
        for (int ai = 0; ai < 2; ++ai)
#pragma unroll
            for (int m = 0; m < 4; ++m) {
                const size_t row = (size_t)(row0 + ai * 128 + m * 16);
                float ss = 0.f;
#pragma unroll
                for (int bj = 0; bj < 2; ++bj) {
                    const size_t off = row * 1024 + col0 + bj * 128;
                    const f32x4 x0 = *(const f32x4*)(x + off), x1 = *(const f32x4*)(x + off + 4);
                    const f32x4 v0 = acc[ai][bj][m][0] + x0, v1 = acc[ai][bj][m][1] + x1;
                    *(f32x4*)(out + off) = v0; *(f32x4*)(out + off + 4) = v1;
                    ss += (v0[0] * v0[0] + v0[1] * v0[1]) + (v0[2] * v0[2] + v0[3] * v0[3]) + (v1[0] * v1[0] + v1[1] * v1[1]) + (v1[2] * v1[2] + v1[3] * v1[3]);
                }
                ss += __shfl_xor(ss, 16); ss += __shfl_xor(ss, 32);
                if (fq == 0) rowss[(size_t)(u.pn * 4 + wc) * M + row] = ss;
            }
    }
};

#include <hip/hip_bf16.h>
#include <cmath>
namespace attn_body {
using bf16=__hip_bfloat16;
using bf16x8=__attribute__((ext_vector_type(8)))short;
using s16x4=__attribute__((ext_vector_type(4)))short;
using f32x16=__attribute__((ext_vector_type(16)))float;
using u32x4=__attribute__((ext_vector_type(4)))unsigned;
constexpr int BATCH=8,NHEAD=8,SEQ=4096,D=64,DM=5632,OPITCH=512;
constexpr int NW=8,QBLK=32,QB=QBLK*NW,KVBLK=64,NQB=SEQ/QB;
constexpr int ATTN_PITCH=DM, ATTN_UNIT_ROWS=QB;
__device__ __forceinline__ int crow(int r,int hi){return (r&3)+8*(r>>2)+4*hi;}
typedef float f32x4_t __attribute__((ext_vector_type(4)));
__device__ __forceinline__ float bf2f_(unsigned short u){return __uint_as_float(((unsigned)u)<<16);}
__device__ __forceinline__ float bflo_(unsigned u){return __uint_as_float(u<<16);}
__device__ __forceinline__ float bfhi_(unsigned u){return __uint_as_float(u&0xffff0000u);}
#define SBAR() __builtin_amdgcn_sched_barrier(0)
__device__ __forceinline__ void cmask(f32x16&p0,f32x16&p1,int jb,int qrel,int hi){
  const float NEG=-INFINITY; int kb=64*jb+4*hi;
  #pragma unroll
  for(int r=0;r<16;++r){int kv=kb+(r&3)+8*(r>>2); if(kv>qrel)p0[r]=NEG; if(kv+32>qrel)p1[r]=NEG;}
}

constexpr int NSLOT=3, SLOTB=8192;
constexpr int LDS_K=0, LDS_V=NSLOT*SLOTB, LDS_WS=2*NSLOT*SLOTB, LDS_OST=LDS_WS+NW*64*4, LDS_KM=LDS_OST+NW*4096, LDS_BYTES=LDS_KM+16*64*4;
constexpr float C2=0.125f*1.4426950408889634f;
__device__ __forceinline__ void glds16(const void*gsrc,unsigned lds_dst){unsigned keep;
  asm volatile("s_mov_b32 %0, m0\n\ts_mov_b32 m0, %2\n\ts_nop 0\n\tglobal_load_lds_dwordx4 %1, off\n\ts_mov_b32 m0, %0":"=&s"(keep):"v"(gsrc),"s"(lds_dst):"memory");}
__device__ __forceinline__ float max3f(float a,float b,float c){float r;asm("v_max3_f32 %0, %1, %2, %3":"=v"(r):"v"(a),"v"(b),"v"(c));return r;}
__device__ __forceinline__ float max2f(float a,float b){float r;asm("v_max_f32_e32 %0, %1, %2":"=v"(r):"v"(a),"v"(b));return r;}
__device__ __forceinline__ float fadd_s(float a,float b){float r;asm("v_add_f32_e32 %0, %1, %2":"=v"(r):"v"(a),"v"(b));return r;}
__device__ __forceinline__ float fsub_s(float a,float b){float r;asm("v_sub_f32_e32 %0, %1, %2":"=v"(r):"v"(a),"v"(b));return r;}
typedef float f32x2_t __attribute__((ext_vector_type(2))); typedef __bf16 bf16x2_t __attribute__((ext_vector_type(2)));
__device__ __forceinline__ unsigned cvtpk_s(float lo,float hi){f32x2_t v={lo,hi};bf16x2_t b=__builtin_convertvector(v,bf16x2_t);return __builtin_bit_cast(unsigned,b);}
#define WAIT_BAR(N) asm volatile("s_waitcnt vmcnt(" #N ") lgkmcnt(0)\n\ts_barrier":::"memory")

__device__ __forceinline__ void qkt(f32x16&p0,f32x16&p1,const char*Kslot,const bf16x8*qr,const f32x16&negm,int r32,int hi){
  const char*kb=Kslot+hi*1024+r32*16;
  #pragma unroll
  for(int d0=0;d0<4;++d0){
    const bf16x8 b0=*reinterpret_cast<const bf16x8*>(kb+d0*2048);
    const bf16x8 b1=*reinterpret_cast<const bf16x8*>(kb+d0*2048+512);
    if(d0==0){p0=__builtin_amdgcn_mfma_f32_32x32x16_bf16(b0,qr[0],negm,0,0,0);p1=__builtin_amdgcn_mfma_f32_32x32x16_bf16(b1,qr[0],negm,0,0,0);}
    else{p0=__builtin_amdgcn_mfma_f32_32x32x16_bf16(b0,qr[d0],p0,0,0,0);p1=__builtin_amdgcn_mfma_f32_32x32x16_bf16(b1,qr[d0],p1,0,0,0);}}
}
typedef __attribute__((address_space(3))) const char* lds_cptr;
typedef short v4i16_t __attribute__((ext_vector_type(4)));
__device__ __forceinline__ void kload8(bf16x8*kf,lds_cptr kp){
  kf[0]=*(const __attribute__((address_space(3))) bf16x8*)(kp);      kf[1]=*(const __attribute__((address_space(3))) bf16x8*)(kp+512);
  kf[2]=*(const __attribute__((address_space(3))) bf16x8*)(kp+2048); kf[3]=*(const __attribute__((address_space(3))) bf16x8*)(kp+2560);
  kf[4]=*(const __attribute__((address_space(3))) bf16x8*)(kp+4096); kf[5]=*(const __attribute__((address_space(3))) bf16x8*)(kp+4608);
  kf[6]=*(const __attribute__((address_space(3))) bf16x8*)(kp+6144); kf[7]=*(const __attribute__((address_space(3))) bf16x8*)(kp+6656);
}
__device__ __forceinline__ void kload2(bf16x8*kf,lds_cptr kp,int j){ kf[2*j]=*(const __attribute__((address_space(3))) bf16x8*)(kp+j*2048); kf[2*j+1]=*(const __attribute__((address_space(3))) bf16x8*)(kp+j*2048+512); }
__device__ __forceinline__ s16x4 vtr(lds_cptr p){ return __builtin_bit_cast(s16x4,__builtin_amdgcn_ds_read_tr16_b64_v4i16((__attribute__((address_space(3))) v4i16_t*)p)); }
__device__ __forceinline__ float rowmax(const f32x16&p0,const f32x16&p1){
  float a=max3f(p0[0],p0[1],p1[0]),b=max3f(p0[2],p0[3],p1[1]);a=max3f(a,p1[2],p1[3]);
  #pragma unroll
  for(int r=4;r<16;r+=4){a=max3f(a,p0[r],p0[r+1]);b=max3f(b,p0[r+2],p0[r+3]);a=max3f(a,p1[r],p1[r+1]);b=max3f(b,p1[r+2],p1[r+3]);}
  const float m=max2f(a,b);
  auto rr=__builtin_amdgcn_permlane32_swap(__float_as_uint(m),__float_as_uint(m),false,false);
  return max2f(__uint_as_float(rr[0]),__uint_as_float(rr[1]));
}
__device__ __forceinline__ void pv(f32x16*o,int vb,bf16x8 pa0,bf16x8 pa1,bf16x8 pa2,bf16x8 pa3){
  #pragma unroll
  for(int d0=0;d0<2;++d0){s16x4 lo[4],hi[4];
    #pragma unroll
    for(int ks=0;ks<4;++ks){
      asm volatile("ds_read_b64_tr_b16 %0,%1 offset:%c2":"=&v"(lo[ks]):"v"(vb),"i"(d0*4096+ks*1024):"memory");
      asm volatile("ds_read_b64_tr_b16 %0,%1 offset:%c2":"=&v"(hi[ks]):"v"(vb),"i"(d0*4096+ks*1024+512):"memory");}
    asm volatile("s_waitcnt lgkmcnt(0)":::"memory");SBAR();
    #define PK(k) (bf16x8){lo[k][0],lo[k][1],lo[k][2],lo[k][3],hi[k][0],hi[k][1],hi[k][2],hi[k][3]}
    o[d0]=__builtin_amdgcn_mfma_f32_32x32x16_bf16(pa0,PK(0),o[d0],0,0,0);
    o[d0]=__builtin_amdgcn_mfma_f32_32x32x16_bf16(pa1,PK(1),o[d0],0,0,0);
    o[d0]=__builtin_amdgcn_mfma_f32_32x32x16_bf16(pa2,PK(2),o[d0],0,0,0);
    o[d0]=__builtin_amdgcn_mfma_f32_32x32x16_bf16(pa3,PK(3),o[d0],0,0,0);
    #undef PK
  }
}

#ifndef ATTN_STORE16
#define ATTN_STORE16(p,v) (*(u32x4*)(p)=(v))
#endif
template<int THRL> __device__ __forceinline__ void attn_unit(int b,int h,int qb,const bf16*Q,const bf16*__restrict__ K,const bf16*__restrict__ V,const bf16*__restrict__ GT,const float*__restrict__ kpart,bf16*O,char*shm){
  const int tid=threadIdx.x,lane=tid&63,r32=lane&31,hi=lane>>5; const int wid=__builtin_amdgcn_readfirstlane(tid>>6);
  const long rowbase=(long)b*SEQ; const int q0=qb*QB;
  const bf16*Qw=Q+(rowbase+q0+wid*QBLK)*DM+h*D;
  const bf16*Kh=K+rowbase*DM+h*D,*Vh=V+rowbase*DM+h*D;
  const unsigned lds0=(unsigned)(uintptr_t)shm;
  float*wsf=(float*)(shm+LDS_WS)+wid*64;
  const bf16*ksrc=Kh+(long)lane*DM+wid*8;
  const bf16*vsrc=Vh+(long)(16*(wid&3)+(lane>>2))*DM+(wid>>2)*32+(lane&3)*8;
  const unsigned kdst=lds0+LDS_K+wid*1024, vdst=lds0+LDS_V+wid*1024;
  #define DMA_K(t,slot) glds16(ksrc+(long)(t)*KVBLK*DM,(unsigned)__builtin_amdgcn_readfirstlane(kdst+(slot)))
  #define DMA_V(t,slot) glds16(vsrc+(long)(t)*KVBLK*DM,(unsigned)__builtin_amdgcn_readfirstlane(vdst+(slot)))
  const int vb0=(int)(lds0+LDS_V)+((lane>>4)&1)*32+(lane&3)*8+(4*hi+((lane&15)>>2))*64;
  const char*Kbase=shm+LDS_K; bf16x8 kf[8];
  const lds_cptr shm3=(lds_cptr)shm; const lds_cptr kp0=shm3+LDS_K+hi*1024+r32*16; const lds_cptr vp0=shm3+LDS_V+((lane>>4)&1)*32+(lane&3)*8+(4*hi+((lane&15)>>2))*64;
  const int NT=(q0+QB)/KVBLK;
  { float*kmw=(float*)(shm+LDS_KM);
    #pragma unroll
    for(int e=0;e<2;++e){ const int idx=tid+512*e, blk=idx>>6, p=idx&63; const float*kp=kpart+(size_t)((b*16+blk)*2)*512+h*64+p; kmw[idx]=kp[0]+kp[512]; } }
  DMA_K(0,0);DMA_V(0,0);DMA_K(1,SLOTB);
  bf16x8 qr[4];
  #pragma unroll
  for(int d0=0;d0<4;++d0)qr[d0]=*reinterpret_cast<const bf16x8*>(&Qw[(long)r32*DM+d0*16+hi*8]);
  float mhat=0.f,l_reg=0.f;f32x16 o[2];o[0]=f32x16{};o[1]=f32x16{};f32x16 negm=f32x16{};asm volatile("":"+v"(negm));
  const int qrel=wid*QBLK+r32;
  #define CMASK(P0,P1,t) do{int jb_=(t)-(NT-4); if(jb_>=0)cmask(P0,P1,jb_,qrel,hi);}while(0)
  bool resc=false;
  #define START(P0,P1) do{ const float rm=rowmax(P0,P1); resc=false; \
    if(__any(rm>(float)THRL)){ const float dl=__builtin_fmaxf(rm,0.f); mhat=fadd_s(mhat,dl); \
      _Pragma("unroll") for(int r=0;r<16;++r){P0[r]=fsub_s(P0[r],dl);P1[r]=fsub_s(P1[r],dl);} } \
    _Pragma("unroll") for(int r=0;r<16;++r)P0[r]=__builtin_amdgcn_exp2f(P0[r]); }while(0)
  #define RESC() do{ if(resc){ asm volatile("s_waitcnt lgkmcnt(0)":::"memory"); \
      _Pragma("unroll") for(int d_=0;d_<2;++d_) _Pragma("unroll") for(int r=0;r<16;++r)o[d_][r]*=wsf[crow(r,hi)]; } }while(0)
  f32x16 pA0,pA1,pB0,pB1;
  int sl_prev=0,sl_cur=0,sl_next=SLOTB;
  #define ROT() do{sl_prev=sl_cur;sl_cur=sl_next;sl_next=(sl_next==(NSLOT-1)*SLOTB)?0:sl_next+SLOTB;}while(0)
  DMA_K(2,2*SLOTB);
  WAIT_BAR(3);
  unsigned selm=1u<<qb;
  { const float*kmr=(const float*)(shm+LDS_KM)+8*hi; float sc[16];
    #pragma unroll
    for(int i=0;i<16;++i){ sc[i]=-INFINITY;
      if(i<qb){ float s=0.f;
        #pragma unroll
        for(int d0=0;d0<4;++d0){ const f32x4_t ka=*(const f32x4_t*)(kmr+i*64+d0*16), kb2=*(const f32x4_t*)(kmr+i*64+d0*16+4);
          #pragma unroll
          for(int e=0;e<4;++e){ s+=bf2f_((unsigned short)qr[d0][e])*ka[e]; s+=bf2f_((unsigned short)qr[d0][4+e])*kb2[e]; } }
        s+=__shfl_xor(s,32); sc[i]=s; } }
    #pragma unroll
    for(int pass=0;pass<3;++pass){ if(pass<qb){ float best=-INFINITY; int bi=0;
      #pragma unroll
      for(int i=0;i<16;++i){ if(i<qb && sc[i]>best){best=sc[i];bi=i;} }
      selm|=1u<<bi;
      #pragma unroll
      for(int i=0;i<16;++i) if(i==bi) sc[i]=-INFINITY; } } }
  #define NEGM_SET(tt) do{ const float nm_=((selm>>((tt)>>2))&1u)?-mhat:-INFINITY; _Pragma("unroll") for(int r=0;r<16;++r)negm[r]=nm_; asm volatile("":"+v"(negm)); }while(0)
  NEGM_SET(0);
  qkt(pA0,pA1,Kbase,qr,negm,r32,hi);asm volatile("s_nop 15\n\ts_nop 7":"+v"(pA0),"+v"(pA1));CMASK(pA0,pA1,0);
  START(pA0,pA1);
  NEGM_SET(1);
  _Pragma("unroll") for(int r=0;r<16;++r)pA1[r]=__builtin_amdgcn_exp2f(pA1[r]);
  WAIT_BAR(0);
  DMA_K(3,0);DMA_V(1,SLOTB);
  ROT();
  kload8(kf,kp0+sl_cur);
  WAIT_BAR(2);
  s16x4 vlo[8],vhi[8]; u32x4 pw0,pw1,pw2,pw3;
  #define PKW(P,B) cvtpk_s(P[B],P[B+1])
  #define PAF(k) __builtin_bit_cast(bf16x8,pw##k)
  #define VFR(i) (bf16x8){vlo[i][0],vlo[i][1],vlo[i][2],vlo[i][3],vhi[i][0],vhi[i][1],vhi[i][2],vhi[i][3]}
  #define PIN(x) asm volatile("":"+v"(x))
  #define MX3(a,b,c) __builtin_fmaxf(__builtin_fmaxf((a),(b)),(c))
  #define GAPA(MF,A0,A1,A2,A3,W0,W1,PW) do{ MF; sacc+=A0; sacc+=A1; sacc+=A2; sacc+=A3; PIN(sacc); W0; W1; PIN(PW); SBAR(); }while(0)
  #define EX(v) __builtin_amdgcn_exp2f(v)
  #define GAPB(MF,X,B) do{ MF; X[B]=EX(X[B]); X[B+1]=EX(X[B+1]); X[B+2]=EX(X[B+2]); X[B+3]=EX(X[B+3]); PIN(X); SBAR(); }while(0)
  #define VRD(i) do{ vlo[i]=vtr(vp_+(((i)>>2)*4096+((i)&3)*1024)); vhi[i]=vtr(vp_+(((i)>>2)*4096+((i)&3)*1024+512)); }while(0)
  #define KRD(G,j) do{ if(G){ kload2(kf,kp0+sl_next,j); SBAR(); } }while(0)
  #define STEP(C0,C1,P0,P1,t,GK,GV,GL) do{ SBAR(); \
    const lds_cptr vp_=vp0+sl_prev; \
    VRD(0); SBAR(); float sacc=(P0[0]+P0[1]); \
    GAPA(C0=__builtin_amdgcn_mfma_f32_32x32x16_bf16(kf[0],qr[0],negm,0,0,0), P0[2],P0[3],P0[4],P0[5],     pw0[0]=PKW(P0,0), pw0[1]=PKW(P0,2), pw0); \
    VRD(4); SBAR(); GAPA(C1=__builtin_amdgcn_mfma_f32_32x32x16_bf16(kf[1],qr[0],negm,0,0,0), P0[6],P0[7],P0[8],P0[9],     pw0[2]=PKW(P0,4), pw0[3]=PKW(P0,6), pw0); \
    VRD(1); SBAR(); GAPA(C0=__builtin_amdgcn_mfma_f32_32x32x16_bf16(kf[2],qr[1],C0,0,0,0),   P0[10],P0[11],P0[12],P0[13], pw1[0]=PKW(P0,8), pw1[1]=PKW(P0,10), pw1); \
    VRD(5); SBAR(); GAPA(C1=__builtin_amdgcn_mfma_f32_32x32x16_bf16(kf[3],qr[1],C1,0,0,0),   P0[14],P0[15],P1[0],P1[1],   pw1[2]=PKW(P0,12),pw1[3]=PKW(P0,14), pw1); \
    VRD(2); SBAR(); GAPA(C0=__builtin_amdgcn_mfma_f32_32x32x16_bf16(kf[4],qr[2],C0,0,0,0),   P1[2],P1[3],P1[4],P1[5],     pw2[0]=PKW(P1,0), pw2[1]=PKW(P1,2), pw2); \
    VRD(6); SBAR(); GAPA(C1=__builtin_amdgcn_mfma_f32_32x32x16_bf16(kf[5],qr[2],C1,0,0,0),   P1[6],P1[7],P1[8],P1[9],     pw2[2]=PKW(P1,4), pw2[3]=PKW(P1,6), pw2); \
    VRD(3); SBAR(); GAPA(C0=__builtin_amdgcn_mfma_f32_32x32x16_bf16(kf[6],qr[3],C0,0,0,0),   P1[10],P1[11],P1[12],P1[13], pw3[0]=PKW(P1,8), pw3[1]=PKW(P1,10), pw3); \
    VRD(7); SBAR(); GAPA(C1=__builtin_amdgcn_mfma_f32_32x32x16_bf16(kf[7],qr[3],C1,0,0,0),   P1[14],P1[15],0.f,0.f,       pw3[2]=PKW(P1,12),pw3[3]=PKW(P1,14), pw3); \
    l_reg+=sacc; \
    if(GK){DMA_K((t)+3,sl_cur);} if(GV){DMA_V((t)+1,sl_next);} \
    CMASK(C0,C1,t); \
    { float a=MX3(C0[0],C0[1],C1[0]),b=MX3(C0[2],C0[3],C1[1]); a=MX3(a,C1[2],C1[3]); \
      _Pragma("unroll") for(int r=4;r<16;r+=4){a=MX3(a,C0[r],C0[r+1]);b=MX3(b,C0[r+2],C0[r+3]);a=MX3(a,C1[r],C1[r+1]);b=MX3(b,C1[r+2],C1[r+3]);} \
      float rm=__builtin_fmaxf(a,b); { auto rr=__builtin_amdgcn_permlane32_swap(__float_as_uint(rm),__float_as_uint(rm),false,false); rm=__builtin_fmaxf(__uint_as_float(rr[0]),__uint_as_float(rr[1])); } \
      resc=false; \
      if(__builtin_expect(__any(rm>(float)THRL),0)){ const float dl=__builtin_fmaxf(rm,0.f); mhat+=dl; \
        _Pragma("unroll") for(int r=0;r<16;++r){C0[r]-=dl;C1[r]-=dl;} \
        const float f=__builtin_amdgcn_exp2f(-dl); l_reg*=f; if(hi==0)wsf[r32]=f; resc=true; } \
      if(resc||((((t)+1)&3)==0)){ NEGM_SET((t)+1); } } \
    SBAR(); \
    GAPB(o[0]=__builtin_amdgcn_mfma_f32_32x32x16_bf16(PAF(0),VFR(0),o[0],0,0,0), C0,0); \
    GAPB(o[1]=__builtin_amdgcn_mfma_f32_32x32x16_bf16(PAF(0),VFR(4),o[1],0,0,0), C0,4); \
    KRD(GL,0); GAPB(o[0]=__builtin_amdgcn_mfma_f32_32x32x16_bf16(PAF(1),VFR(1),o[0],0,0,0), C0,8); \
    KRD(GL,1); GAPB(o[1]=__builtin_amdgcn_mfma_f32_32x32x16_bf16(PAF(1),VFR(5),o[1],0,0,0), C0,12); \
    KRD(GL,2); GAPB(o[0]=__builtin_amdgcn_mfma_f32_32x32x16_bf16(PAF(2),VFR(2),o[0],0,0,0), C1,0); \
    KRD(GL,3); GAPB(o[1]=__builtin_amdgcn_mfma_f32_32x32x16_bf16(PAF(2),VFR(6),o[1],0,0,0), C1,4); \
    GAPB(o[0]=__builtin_amdgcn_mfma_f32_32x32x16_bf16(PAF(3),VFR(3),o[0],0,0,0), C1,8); \
    GAPB(o[1]=__builtin_amdgcn_mfma_f32_32x32x16_bf16(PAF(3),VFR(7),o[1],0,0,0), C1,12); \
    }while(0)
  int t=1;
  #undef CMASK
  #define CMASK(P0,P1,t) do{}while(0)
  for(;t+5<NT;t+=2){
    STEP(pB0,pB1,pA0,pA1,t,true,true,true);     WAIT_BAR(2); RESC(); ROT();
    STEP(pA0,pA1,pB0,pB1,t+1,true,true,true);   WAIT_BAR(2); RESC(); ROT();
  }
  #undef CMASK
  #define CMASK(P0,P1,t) do{int jb_=(t)-(NT-4); if(jb_>=0)cmask(P0,P1,jb_,qrel,hi);}while(0)
  #define ENDW(tt) do{ if((tt)+3<NT){WAIT_BAR(2);} else if((tt)+2<NT){WAIT_BAR(1);} else {WAIT_BAR(0);} }while(0)
  for(;t+1<NT;t+=2){
    STEP(pB0,pB1,pA0,pA1,t,(t+3<NT),(t+1<NT),(t+1<NT));       ENDW(t);   RESC(); ROT();
    STEP(pA0,pA1,pB0,pB1,t+1,(t+4<NT),(t+2<NT),(t+2<NT));     ENDW(t+1); RESC(); ROT();
  }
  STEP(pB0,pB1,pA0,pA1,NT-1,false,false,false); RESC();
  { float sacc=pB0[0]+pB0[1]; _Pragma("unroll") for(int r=2;r<16;++r)sacc+=pB0[r]; _Pragma("unroll") for(int r=0;r<16;++r)sacc+=pB1[r]; l_reg+=sacc;
    pw0=(u32x4){PKW(pB0,0),PKW(pB0,2),PKW(pB0,4),PKW(pB0,6)};pw1=(u32x4){PKW(pB0,8),PKW(pB0,10),PKW(pB0,12),PKW(pB0,14)};pw2=(u32x4){PKW(pB1,0),PKW(pB1,2),PKW(pB1,4),PKW(pB1,6)};pw3=(u32x4){PKW(pB1,8),PKW(pB1,10),PKW(pB1,12),PKW(pB1,14)};
    SBAR(); pv(o,vb0+sl_cur,PAF(0),PAF(1),PAF(2),PAF(3)); }
  #undef PKW
  #undef PAF
  #undef VFR
  #undef PIN
  #undef MX3
  #undef GAPA
  #undef GAPB
  #undef EX
  #undef VRD
  #undef KRD
  #undef STEP
  #undef ENDW
  {auto rr=__builtin_amdgcn_permlane32_swap(__float_as_uint(l_reg),__float_as_uint(l_reg),false,false);l_reg=__uint_as_float(rr[0])+__uint_as_float(rr[1]);}
  if(hi==0)wsf[32+r32]=l_reg;asm volatile("s_waitcnt lgkmcnt(0)":::"memory");
  float rli[16];
  #pragma unroll
  for(int r=0;r<16;++r)rli[r]=__builtin_amdgcn_rcpf(wsf[32+crow(r,hi)]);
  bf16*Ow=O+(rowbase+q0+wid*QBLK)*OPITCH+h*D; const bf16*Gw=GT+(rowbase+q0+wid*QBLK)*DM+h*D;
  { bf16*stg=(bf16*)(shm+LDS_OST)+wid*2048;
    #pragma unroll
    for(int r=0;r<16;++r){const int orow=crow(r,hi);
      #pragma unroll
      for(int d0=0;d0<2;++d0)stg[orow*64+d0*32+r32]=__float2bfloat16(o[d0][r]*rli[r]);}
    asm volatile("s_waitcnt lgkmcnt(0)":::"memory");
    #pragma unroll
    for(int i=0;i<4;++i){const int row=i*8+(lane>>3),ch=lane&7; const u32x4 v=*(const u32x4*)(stg+row*64+ch*8); const u32x4 g=*(const u32x4*)(Gw+(long)row*DM+ch*8); u32x4 w;
      w.x=cvtpk_s(bflo_(v.x)*bflo_(g.x),bfhi_(v.x)*bfhi_(g.x)); w.y=cvtpk_s(bflo_(v.y)*bflo_(g.y),bfhi_(v.y)*bfhi_(g.y)); w.z=cvtpk_s(bflo_(v.z)*bflo_(g.z),bfhi_(v.z)*bfhi_(g.z)); w.w=cvtpk_s(bflo_(v.w)*bflo_(g.w),bfhi_(v.w)*bfhi_(g.w));
      ATTN_STORE16(Ow+(long)row*OPITCH+ch*8,w);} }
  asm volatile("s_waitcnt lgkmcnt(0)\n\ts_barrier":::"memory");
  #undef DMA_K
  #undef DMA_V
  #undef CMASK
  #undef START
  #undef RESC
  #undef ROT
  #undef NEGM_SET
}
constexpr int ATTN_LDS_BYTES=LDS_BYTES;
struct AttnTensors { const bf16* Q; const bf16* K; const bf16* V; const bf16* GT; const float* kpart; bf16* O; };
struct AttnUnit { int bh; int qb; };
struct StaticOrder {
  int vcu, G;
  __device__ __forceinline__ explicit StaticOrder(int grid,int block):vcu((grid%8==0)?(block%8)*(grid/8)+block/8:block),G(grid){}
  __device__ __forceinline__ bool next(int i,AttnUnit&u)const{
    if(G==256){ if(i>=4)return false; const int s=vcu&3; u.bh=vcu>>2; u.qb=(i==0)?s:(i==1)?7-s:(i==2)?8+s:15-s; return true; }
    const int uu=vcu+i*G; if(uu>=BATCH*NHEAD*NQB)return false; u.bh=uu>>4; u.qb=uu&15; return true; }
  __device__ __forceinline__ void a_ready(const AttnUnit&)const{}
  __device__ __forceinline__ void done(const AttnUnit&)const{}
};
template<class Sched,int THRL=8> __device__ __forceinline__ void attn_phase(char*lds,const AttnTensors&T,const Sched&S){
  AttnUnit u;
  for(int i=0;S.next(i,u);++i){ S.a_ready(u); attn_unit<THRL>(u.bh/NHEAD,u.bh%NHEAD,u.qb,T.Q,T.K,T.V,T.GT,T.kpart,T.O,lds); S.done(u); }
}
#undef SBAR
#undef WAIT_BAR
}
constexpr int NWAVES = 8;
constexpr size_t MiB = 1u << 20;
constexpr size_t WS_PROJ = 0, WS_OA = 352 * MiB, WS_OB = 384 * MiB, WS_MERGED = 416 * MiB, WS_XN = 416 * MiB, WS_GFG = 480 * MiB, WS_RSTD = 482 * MiB, WS_KMEAN = 483 * MiB;
constexpr size_t WS_WIN = 484 * MiB, WS_WA = 496 * MiB, WS_WB = 497 * MiB, WS_WO = 498 * MiB, WS_COS = 500 * MiB, WS_SIN = WS_COS + 512 * 1024, WS_KPART = 501 * MiB, WS_QKHP = WS_KPART + 512 * 1024;
constexpr size_t WS_CTL = 502 * MiB, CTL_ZERO_BYTES = 1 * MiB, WS_ROWSS = 504 * MiB, WS_END = 512 * MiB;
constexpr int CW_TMO = 0, CW_CODE = 1, CW_BAR = 4096;
constexpr int RING_OFF = 0, RING_BYTES = 131072;
constexpr int LDSCTL_OFF = RING_BYTES, MISC_OFF = LDSCTL_OFF + 320;
constexpr int LDS_BYTES = 147456;

struct Frame {
    LAS unsigned char* lds;
    volatile LAS unsigned* MISC;
    gu32* ctl;
    int tid, lane, wave;
    int vcu, G;
    const float *x, *norm_in_g, *w_in, *b_merge, *w_fg2, *b_fg, *gla_norm_g, *w_proj_a, *w_proj_b, *w_out, *norm_f_g;
    float* out;
    unsigned char* ws;
};

__device__ __forceinline__ float wave_sum(float v) {
#pragma unroll
    for (int o = 1; o < 64; o <<= 1) v += __shfl_xor(v, o);
    return v;
}
__device__ __forceinline__ float wave_max(float v) {
#pragma unroll
    for (int o = 1; o < 64; o <<= 1) v = fmaxf(v, __shfl_xor(v, o));
    return v;
}
typedef __bf16 bf16x2_t __attribute__((ext_vector_type(2)));
__device__ __forceinline__ float dot2_bf16(unsigned w, unsigned x, float acc) { return __builtin_amdgcn_fdot2_f32_bf16(__builtin_bit_cast(bf16x2_t, w), __builtin_bit_cast(bf16x2_t, x), acc, false); }

__device__ __forceinline__ void sincos_acc(float a, float& s, float& c) {
    const double ad = (double)a;
    const double q = __builtin_rint(ad * 0.63661977236758134308);
    const float r = (float)(ad - q * 1.57079632679489661923);
    const float r2 = r * r;
    float sp = r2 * (1.f / 362880.f) - (1.f / 5040.f); sp = sp * r2 + (1.f / 120.f); sp = sp * r2 - (1.f / 6.f); sp = sp * r2 * r + r;
    float cp = -r2 * (1.f / 3628800.f) + (1.f / 40320.f); cp = cp * r2 - (1.f / 720.f); cp = cp * r2 + (1.f / 24.f); cp = cp * r2 - 0.5f; cp = cp * r2 + 1.f;
    const int qi = ((int)q) & 3;
    s = (qi == 0) ? sp : (qi == 1) ? cp : (qi == 2) ? -sp : -cp;
    c = (qi == 0) ? cp : (qi == 1) ? -sp : (qi == 2) ? -cp : sp;
}

__device__ __forceinline__ int inproj_src_col(int n) {
    if (n < 1024) { const int p = n & 63; return (n & ~63) + 32 * ((p >> 2) & 1) + 16 * (p >> 5) + 4 * ((p >> 3) & 3) + (p & 3); }
    return n < C_FG ? n : n + 16;
}
template <bool MAP>
__device__ __forceinline__ void p0_transpose_item(const float* W, int K, int ldw, int Nout, bf16_t* WT, LAS float* scr, int item, int lane) {
    const int nblk = Nout / 32, kb = item / nblk, nb = item % nblk, k0 = 64 * kb, n0 = 32 * nb;
    const int nsrc = MAP ? inproj_src_col(n0 + (lane & 31)) : n0 + (lane & 31);
#pragma unroll 8
    for (int i = 0; i < 32; ++i) { const int kk = 2 * i + (lane >> 5); scr[kk * 33 + (lane & 31)] = W[(size_t)(k0 + kk) * ldw + nsrc]; }
    LDS_WAIT(); asm volatile("" ::: "memory");
    const int c = lane & 7;
#pragma unroll
    for (int j = 0; j < 4; ++j) { const int n = (lane >> 3) + 8 * j; const LAS float* s = scr + (8 * c) * 33 + n;
        v4u o; o.x = pk2(s[0 * 33], s[1 * 33]); o.y = pk2(s[2 * 33], s[3 * 33]); o.z = pk2(s[4 * 33], s[5 * 33]); o.w = pk2(s[6 * 33], s[7 * 33]);
        *(GAS v4u*)(WT + (size_t)(n0 + n) * K + k0 + 8 * c) = o; }
    LDS_WAIT(); asm volatile("" ::: "memory");
}

constexpr int P0_SCR_BYTES = 8704;
constexpr int P0_WFG_OFF = 8 * P0_SCR_BYTES;
__device__ __forceinline__ void p0_prologue(Frame& F) {
    LAS float* scr = (LAS float*)(F.lds + RING_OFF + F.wave * P0_SCR_BYTES);
    LAS unsigned* wfg = (LAS unsigned*)(F.lds + RING_OFF + P0_WFG_OFF);
    unsigned char* ws = F.ws;
    bf16_t* WinT = (bf16_t*)(ws + WS_WIN); bf16_t* WaT = (bf16_t*)(ws + WS_WA); bf16_t* WbT = (bf16_t*)(ws + WS_WB); bf16_t* WoT = (bf16_t*)(ws + WS_WO);
    bf16_t* XN = (bf16_t*)(ws + WS_XN); float* gfg = (float*)(ws + WS_GFG); float* cosT = (float*)(ws + WS_COS); float* sinT = (float*)(ws + WS_SIN); float* qkhp = (float*)(ws + WS_QKHP);
    const int gw = F.vcu * NWAVES + F.wave, NGW = F.G * NWAVES;
    for (int idx = F.tid; idx < 8192; idx += NWAVES * 64) {
        const int e = idx & 3, l = (idx >> 2) & 63, c = (idx >> 8) & 3, q = idx >> 10;
        const int k0 = 256 * (q >> 1) + 4 * l + 2 * (q & 1), n = 4 * c + e;
        wfg[idx] = pk2(F.w_in[(size_t)k0 * N_IN + C_FG + n], F.w_in[(size_t)(k0 + 1) * N_IN + C_FG + n]);
    }
    for (int idx = F.vcu * (NWAVES * 64) + F.tid; idx < SEQ * 32; idx += F.G * NWAVES * 64) {
        const int pos = idx >> 5, f = idx & 31;
        const float invf = 1.0f / powf(10000.0f, (float)f * (1.0f / 32.0f));
        float sn, cs; sincos_acc((float)pos * invf, sn, cs);
        cosT[idx] = cs; sinT[idx] = sn;
    }
    constexpr int I_IN = (D_MODEL / 64) * (NP / 32), I_A = (512 / 64) * (1024 / 32), I_O = (1024 / 64) * (1024 / 32);
    constexpr int NITEMS = I_IN + 2 * I_A + I_O;
    for (int it = gw; it < NITEMS; it += NGW) {
        int r = it;
        if (r < I_IN) { p0_transpose_item<true>(F.w_in, D_MODEL, N_IN, NP, WinT, scr, r, F.lane); continue; } r -= I_IN;
        if (r < I_A) { p0_transpose_item<false>(F.w_proj_a, 512, 1024, 1024, WaT, scr, r, F.lane); continue; } r -= I_A;
        if (r < I_A) { p0_transpose_item<false>(F.w_proj_b, 512, 1024, 1024, WbT, scr, r, F.lane); continue; } r -= I_A;
        p0_transpose_item<false>(F.w_out, 1024, 1024, 1024, WoT, scr, r, F.lane);
    }
    for (int task = gw; task < 16 * 128; task += NGW) {
        const int r16 = task >> 7, cg = task & 127;
        const size_t row = (size_t)(r16 >> 1) * SEQ + (r16 & 1);
        const GAS f32x4* xr = (const GAS f32x4*)(F.x + row * D_MODEL) + F.lane;
        const GAS f32x4* gr = (const GAS f32x4*)F.norm_in_g + F.lane;
        f32x4 v[4]; float s = 0.f;
#pragma unroll
        for (int j = 0; j < 4; ++j) { v[j] = xr[64 * j]; s += (v[j].x * v[j].x + v[j].y * v[j].y) + (v[j].z * v[j].z + v[j].w * v[j].w); }
        const float rstd = rsqrtf(wave_sum(s) * (1.f / D_MODEL) + RMS_EPS);
        f32x4 a = (f32x4){0.f, 0.f, 0.f, 0.f};
#pragma unroll
        for (int j = 0; j < 4; ++j) { const f32x4 h = v[j] * rstd * gr[64 * j];
#pragma unroll
            for (int i = 0; i < 4; ++i) { const f32x4 w4 = *(const GAS f32x4*)(F.w_in + (size_t)(256 * j + 4 * F.lane + i) * N_IN + P_GQ + 4 * cg); a += w4 * h[i]; } }
        a[0] = wave_sum(a[0]); a[1] = wave_sum(a[1]); a[2] = wave_sum(a[2]); a[3] = wave_sum(a[3]);
        if (F.lane == 0) *(GAS f32x4*)(qkhp + (size_t)r16 * 512 + 4 * cg) = a;
    }
    __syncthreads();
    for (int m = gw; m < M; m += NGW) {
        const GAS f32x4* xr = (const GAS f32x4*)(F.x + (size_t)m * D_MODEL) + F.lane;
        const GAS f32x4* gr = (const GAS f32x4*)F.norm_in_g + F.lane;
        f32x4 v[4]; float s = 0.f;
#pragma unroll
        for (int j = 0; j < 4; ++j) { v[j] = xr[64 * j]; s += (v[j].x * v[j].x + v[j].y * v[j].y) + (v[j].z * v[j].z + v[j].w * v[j].w); }
        const float rstd = rsqrtf(wave_sum(s) * (1.f / D_MODEL) + RMS_EPS);
        unsigned xp[8];
        GAS unsigned long long* o8 = (GAS unsigned long long*)(XN + (size_t)m * D_MODEL) + F.lane;
#pragma unroll
        for (int j = 0; j < 4; ++j) { const f32x4 h = v[j] * rstd * gr[64 * j]; xp[2 * j] = pk2(h.x, h.y); xp[2 * j + 1] = pk2(h.z, h.w);
            o8[64 * j] = (unsigned long long)xp[2 * j] | ((unsigned long long)xp[2 * j + 1] << 32); }
        float a[16];
#pragma unroll
        for (int n = 0; n < 16; ++n) a[n] = 0.f;
#pragma unroll
        for (int q = 0; q < 8; ++q)
#pragma unroll
            for (int c = 0; c < 4; ++c) { const v4u wv = *(const LAS v4u*)(wfg + ((q * 4 + c) * 64 + F.lane) * 4);
                a[4 * c + 0] = dot2_bf16(wv.x, xp[q], a[4 * c + 0]); a[4 * c + 1] = dot2_bf16(wv.y, xp[q], a[4 * c + 1]);
                a[4 * c + 2] = dot2_bf16(wv.z, xp[q], a[4 * c + 2]); a[4 * c + 3] = dot2_bf16(wv.w, xp[q], a[4 * c + 3]); }
        { const bool b5 = (F.lane >> 5) & 1, b4 = (F.lane >> 4) & 1, b3 = (F.lane >> 3) & 1, b2 = (F.lane >> 2) & 1;
#pragma unroll
          for (int n = 0; n < 8; ++n) { const float keep = b5 ? a[n + 8] : a[n], send = b5 ? a[n] : a[n + 8]; a[n] = keep + __shfl_xor(send, 32); }
#pragma unroll
          for (int n = 0; n < 4; ++n) { const float keep = b4 ? a[n + 4] : a[n], send = b4 ? a[n] : a[n + 4]; a[n] = keep + __shfl_xor(send, 16); }
#pragma unroll
          for (int n = 0; n < 2; ++n) { const float keep = b3 ? a[n + 2] : a[n], send = b3 ? a[n] : a[n + 2]; a[n] = keep + __shfl_xor(send, 8); }
          { const float keep = b2 ? a[1] : a[0], send = b2 ? a[0] : a[1]; a[0] = keep + __shfl_xor(send, 4); }
          a[0] += __shfl_xor(a[0], 2); a[0] += __shfl_xor(a[0], 1); }
        if ((F.lane & 3) == 0) gfg[(size_t)m * 16 + (F.lane >> 2)] = a[0];
    }
}


namespace gla {
typedef short bf16x8 __attribute__((ext_vector_type(8)));
typedef float f32x16 __attribute__((ext_vector_type(16)));
typedef __attribute__((address_space(3))) unsigned char* ldsp;
constexpr int LP = 144;
constexpr int L_QS = 0, L_KS = 9216, L_AT = 18432, L_VT = 27648, L_ST = 46080, L_AS = 64512, L_O = 73728, L_BB = 107520, L_CC = 108032;
constexpr int OP = 132;
__device__ __forceinline__ int crow(int r, int hi) { return (r & 3) + 8 * (r >> 2) + 4 * hi; }
__device__ __forceinline__ float bflo(unsigned u) { return __uint_as_float(u << 16); }
__device__ __forceinline__ float bfhi(unsigned u) { return __uint_as_float(u & 0xffff0000u); }
__device__ __forceinline__ f32x16 mm32(f32x16 c, ldsp A, ldsp B, int lane) {
    const int r = lane & 31, hi = lane >> 5;
#pragma unroll
    for (int s2 = 0; s2 < 4; ++s2) {
        const bf16x8 a = *(const __attribute__((address_space(3))) bf16x8*)(A + r * LP + s2 * 32 + hi * 16);
        const bf16x8 b = *(const __attribute__((address_space(3))) bf16x8*)(B + r * LP + s2 * 32 + hi * 16);
        c = __builtin_amdgcn_mfma_f32_32x32x16_bf16(a, b, c, 0, 0, 0);
    }
    return c;
}
struct Ctx { const bf16_t* proj; const float* gfg; const float* wfg2; const float* bfg; const float* gnorm; const float* qkhp; bf16_t* LT; float* DEC; bf16_t* ST; bf16_t* ob; };

template <bool PHASE_C>
__device__ __forceinline__ void stage(ldsp lds, const Ctx& X, int bh, int c, int tid, int lane, int w) {
    const int b = bh >> 2, h = bh & 3;
    const size_t row0 = (size_t)b * SEQ + (size_t)c * 64, row = row0 + lane;
    f32x4 g4[4];
#pragma unroll
    for (int i = 0; i < 4; ++i) g4[i] = *(const f32x4*)(X.gfg + row * 16 + 4 * i);
    float z[8];
    { const f32x4 ba = *(const f32x4*)(X.bfg + h * 64 + 8 * w), bb = *(const f32x4*)(X.bfg + h * 64 + 8 * w + 4);
#pragma unroll
      for (int e = 0; e < 4; ++e) { z[e] = ba[e]; z[4 + e] = bb[e]; } }
#pragma unroll
    for (int r = 0; r < 16; ++r) {
        const float gr = g4[r >> 2][r & 3];
        const f32x4 wa = *(const f32x4*)(X.wfg2 + r * 256 + h * 64 + 8 * w), wb = *(const f32x4*)(X.wfg2 + r * 256 + h * 64 + 8 * w + 4);
#pragma unroll
        for (int e = 0; e < 4; ++e) { z[e] += gr * wa[e]; z[4 + e] += gr * wb[e]; }
    }
    float bc[8];
#pragma unroll
    for (int e = 0; e < 8; ++e) {
        float v = (fminf(z[e], 0.f) - __logf(1.f + __expf(-fabsf(z[e])))) * (1.f / 16.f);
#pragma unroll
        for (int off = 1; off < 64; off <<= 1) { const float n = __shfl_up(v, off); if (lane >= off) v += n; }
        bc[e] = v;
    }
    const u32x4 kraw = *(const u32x4*)(X.proj + row * NP + P_GK + h * 64 + 8 * w);
    float kf[8] = {bflo(kraw.x), bfhi(kraw.x), bflo(kraw.y), bfhi(kraw.y), bflo(kraw.z), bfhi(kraw.z), bflo(kraw.w), bfhi(kraw.w)};
    if (PHASE_C) {
        const u32x4 qraw = *(const u32x4*)(X.proj + row * NP + P_GQ + h * 64 + 8 * w);
        float qf[8] = {bflo(qraw.x), bfhi(qraw.x), bflo(qraw.y), bfhi(qraw.y), bflo(qraw.z), bfhi(qraw.z), bflo(qraw.w), bfhi(qraw.w)};
        float eq[8], ek[8];
#pragma unroll
        for (int e = 0; e < 8; ++e) { eq[e] = qf[e] * __expf(bc[e]); ek[e] = kf[e] * __expf(-bc[e]); }
        u32x4 wq, wk;
        wq.x = cvt_pk_bf16(eq[0], eq[1]); wq.y = cvt_pk_bf16(eq[2], eq[3]); wq.z = cvt_pk_bf16(eq[4], eq[5]); wq.w = cvt_pk_bf16(eq[6], eq[7]);
        wk.x = cvt_pk_bf16(ek[0], ek[1]); wk.y = cvt_pk_bf16(ek[2], ek[3]); wk.z = cvt_pk_bf16(ek[4], ek[5]); wk.w = cvt_pk_bf16(ek[6], ek[7]);
        *(__attribute__((address_space(3))) u32x4*)(lds + L_QS + lane * LP + 16 * w) = wq;
        *(__attribute__((address_space(3))) u32x4*)(lds + L_KS + lane * LP + 16 * w) = wk;
        if (c == 0 && lane < 2) {
#pragma unroll
            for (int e = 0; e < 8; ++e) ((__attribute__((address_space(3))) float*)(lds + L_BB))[lane * 64 + 8 * w + e] = bc[e];
        }
    } else {
#pragma unroll
        for (int e = 0; e < 8; ++e) {
            const float bl = __shfl(bc[e], 63);
            *(__attribute__((address_space(3))) unsigned short*)(lds + L_AT + (8 * w + e) * LP + 2 * lane) = (unsigned short)f2bf(kf[e] * __expf(bl - bc[e]));
            if (lane == 63) X.DEC[((size_t)bh * 64 + c) * 64 + 8 * w + e] = __expf(bl);
        }
    }
    { const u32x4 va = *(const u32x4*)(X.proj + row * NP + P_GV + h * 128 + 16 * w), vb = *(const u32x4*)(X.proj + row * NP + P_GV + h * 128 + 16 * w + 8);
      const unsigned vv[8] = {va.x, va.y, va.z, va.w, vb.x, vb.y, vb.z, vb.w};
#pragma unroll
      for (int i = 0; i < 8; ++i) {
          *(__attribute__((address_space(3))) unsigned short*)(lds + L_VT + (16 * w + 2 * i) * LP + 2 * lane) = (unsigned short)(vv[i] & 0xffffu);
          *(__attribute__((address_space(3))) unsigned short*)(lds + L_VT + (16 * w + 2 * i + 1) * LP + 2 * lane) = (unsigned short)(vv[i] >> 16);
      } }
}

__device__ __forceinline__ void unit_a(ldsp lds, const Ctx& X, int bh, int c, int tid, int lane, int w) {
    stage<false>(lds, X, bh, c, tid, lane, w);
    __syncthreads();
    const int rt = w >> 2, ct = w & 3, cc = lane & 31, hi = lane >> 5;
    f32x16 acc;
#pragma unroll
    for (int r = 0; r < 16; ++r) acc[r] = 0.f;
    acc = mm32(acc, lds + L_AT + rt * 32 * LP, lds + L_VT + ct * 32 * LP, lane);
    bf16_t* dst = X.LT + (((size_t)bh * 64 + c) * 128 + ct * 32 + cc) * 64 + rt * 32 + 4 * hi;
#pragma unroll
    for (int g = 0; g < 4; ++g) {
        unsigned long long v = (unsigned long long)cvt_pk_bf16(acc[4 * g], acc[4 * g + 1]) | ((unsigned long long)cvt_pk_bf16(acc[4 * g + 2], acc[4 * g + 3]) << 32);
        *(unsigned long long*)(dst + 8 * g) = v;
    }
    __syncthreads();
}

__device__ __forceinline__ void scan_b(const Ctx& X, int gtid, int gthreads) {
    for (int idx = gtid; idx < 32 * 128 * 16; idx += gthreads) {
        const int bh = idx >> 11, dv = (idx >> 4) & 127, dq = idx & 15;
        float s0 = 0.f, s1 = 0.f, s2 = 0.f, s3 = 0.f;
#pragma unroll 8
        for (int c = 0; c < 64; ++c) {
            const size_t o = (((size_t)bh * 64 + c) * 128 + dv) * 64 + 4 * dq;
            const unsigned long long l = *(const unsigned long long*)(X.LT + o);
            const f32x4 d = *(const f32x4*)(X.DEC + ((size_t)bh * 64 + c) * 64 + 4 * dq);
            *(unsigned long long*)(X.ST + o) = (unsigned long long)cvt_pk_bf16(s0, s1) | ((unsigned long long)cvt_pk_bf16(s2, s3) << 32);
            s0 = d[0] * s0 + bflo((unsigned)l); s1 = d[1] * s1 + bfhi((unsigned)l); s2 = d[2] * s2 + bflo((unsigned)(l >> 32)); s3 = d[3] * s3 + bfhi((unsigned)(l >> 32));
        }
    }
}

__device__ __forceinline__ void unit_c(ldsp lds, const Ctx& X, int bh, int c, int tid, int lane, int w) {
    const int b = bh >> 2, h = bh & 3;
    const size_t row0 = (size_t)b * SEQ + (size_t)c * 64;
    stage<true>(lds, X, bh, c, tid, lane, w);
    { const int r = tid >> 2, q4 = tid & 3;
      const bf16_t* src = X.ST + (((size_t)bh * 64 + c) * 128 + r) * 64 + 16 * q4;
      const u32x4 a = *(const u32x4*)src, bq = *(const u32x4*)(src + 8);
      *(__attribute__((address_space(3))) u32x4*)(lds + L_ST + r * LP + 32 * q4) = a;
      *(__attribute__((address_space(3))) u32x4*)(lds + L_ST + r * LP + 32 * q4 + 16) = bq; }
    __syncthreads();
    const int rt = w >> 2, ct = w & 3, cc = lane & 31, hi = lane >> 5;
    f32x16 co;
#pragma unroll
    for (int r = 0; r < 16; ++r) co[r] = 0.f;
    co = mm32(co, lds + L_QS + rt * 32 * LP, lds + L_ST + ct * 32 * LP, lane);
    if (w < 4) {
        const int rt2 = w >> 1, ct2 = w & 1;
        f32x16 ca;
#pragma unroll
        for (int r = 0; r < 16; ++r) ca[r] = 0.f;
        ca = mm32(ca, lds + L_QS + rt2 * 32 * LP, lds + L_KS + ct2 * 32 * LP, lane);
        const int sidx = ct2 * 32 + cc;
#pragma unroll
        for (int r = 0; r < 16; ++r) { const int t = rt2 * 32 + crow(r, hi);
            *(__attribute__((address_space(3))) unsigned short*)(lds + L_AS + t * LP + 2 * sidx) = (unsigned short)f2bf(sidx <= t ? ca[r] : 0.f); }
    }
    __syncthreads();
    co = mm32(co, lds + L_AS + rt * 32 * LP, lds + L_VT + ct * 32 * LP, lane);
    { __attribute__((address_space(3))) float* O = (__attribute__((address_space(3))) float*)(lds + L_O);
#pragma unroll
      for (int r = 0; r < 16; ++r) O[(rt * 32 + crow(r, hi)) * OP + ct * 32 + cc] = co[r]; }
    __syncthreads();
    if (c == 0) {
        __attribute__((address_space(3))) float* CC = (__attribute__((address_space(3))) float*)(lds + L_CC);
        if (w == 0) {
            const __attribute__((address_space(3))) float* BB = (const __attribute__((address_space(3))) float*)(lds + L_BB);
            const float* hp0 = X.qkhp + (size_t)(b * 2) * 512 + h * 64 + lane; const float* hp1 = hp0 + 512;
            const float q0 = hp0[0], k0 = hp0[256], q1 = hp1[0], k1 = hp1[256];
            const float c00 = wave_sum(q0 * k0) * 0.125f, c11 = wave_sum(q1 * k1) * 0.125f, c10 = wave_sum(q1 * k0 * __expf(BB[64 + lane] - BB[lane])) * 0.125f;
            if (lane == 0) { CC[0] = c00; CC[1] = c10; CC[2] = c11; }
        }
        __syncthreads();
        if (tid < 128) {
            __attribute__((address_space(3))) float* O = (__attribute__((address_space(3))) float*)(lds + L_O);
            const unsigned vv = *(const __attribute__((address_space(3))) unsigned*)(lds + L_VT + tid * LP);
            const float v0 = bflo(vv), v1 = bfhi(vv);
            O[tid] = CC[0] * v0; O[OP + tid] = CC[1] * v0 + CC[2] * v1;
        }
        __syncthreads();
    }
    { const int t = tid >> 3, ch = tid & 7;
      const __attribute__((address_space(3))) float* O = (const __attribute__((address_space(3))) float*)(lds + L_O) + t * OP + 16 * ch;
      f32x4 o4[4]; float ss = 0.f;
#pragma unroll
      for (int i = 0; i < 4; ++i) { o4[i] = *(const __attribute__((address_space(3))) f32x4*)(O + 4 * i); ss += (o4[i][0] * o4[i][0] + o4[i][1] * o4[i][1]) + (o4[i][2] * o4[i][2] + o4[i][3] * o4[i][3]); }
      ss += __shfl_xor(ss, 1); ss += __shfl_xor(ss, 2); ss += __shfl_xor(ss, 4);
      const float rs = rsqrtf(ss * (1.f / 128.f) + RMS_EPS);
      const bf16_t* gp = X.proj + (row0 + t) * NP + P_GG + h * 128 + 16 * ch;
      const u32x4 ga = *(const u32x4*)gp, gb = *(const u32x4*)(gp + 8);
      const unsigned gv[8] = {ga.x, ga.y, ga.z, ga.w, gb.x, gb.y, gb.z, gb.w};
      unsigned outw[8];
#pragma unroll
      for (int i = 0; i < 4; ++i) { const f32x4 gn = *(const f32x4*)(X.gnorm + 16 * ch + 4 * i);
          outw[2 * i] = cvt_pk_bf16(o4[i][0] * rs * gn[0] * bflo(gv[2 * i]), o4[i][1] * rs * gn[1] * bfhi(gv[2 * i]));
          outw[2 * i + 1] = cvt_pk_bf16(o4[i][2] * rs * gn[2] * bflo(gv[2 * i + 1]), o4[i][3] * rs * gn[3] * bfhi(gv[2 * i + 1])); }
      bf16_t* op = X.ob + (row0 + t) * 512 + h * 128 + 16 * ch;
      *(u32x4*)op = (u32x4){outw[0], outw[1], outw[2], outw[3]}; *(u32x4*)(op + 8) = (u32x4){outw[4], outw[5], outw[6], outw[7]}; }
    __syncthreads();
}
}

struct Args { const float* in[11]; float* out; unsigned char* ws; int ph_lo, ph_hi, li, pad; };
__global__ void __launch_bounds__(NWAVES * 64, 2) mk_fwd(Args args) {
    extern __shared__ __attribute__((aligned(16))) unsigned char lds[];
    Frame F;
    F.lds = (LAS unsigned char*)lds;
    F.MISC = (volatile LAS unsigned*)(F.lds + MISC_OFF);
    F.tid = threadIdx.x; F.lane = F.tid & 63; F.wave = __builtin_amdgcn_readfirstlane(F.tid >> 6);
    F.G = gridDim.x; { const int bx = blockIdx.x; F.vcu = (F.G % 8 == 0) ? (bx % 8) * (F.G / 8) + bx / 8 : bx; }
    unsigned char* ws = args.ws; F.ws = ws;
    F.ctl = (gu32*)(ws + WS_CTL);
    F.x = args.in[0]; F.norm_in_g = args.in[1]; F.w_in = args.in[2]; F.b_merge = args.in[3]; F.w_fg2 = args.in[4]; F.b_fg = args.in[5];
    F.gla_norm_g = args.in[6]; F.w_proj_a = args.in[7]; F.w_proj_b = args.in[8]; F.w_out = args.in[9]; F.norm_f_g = args.in[10]; F.out = args.out;
    for (int u = F.tid; u < (LDS_BYTES - LDSCTL_OFF) / 4; u += NWAVES * 64) ((LAS unsigned*)(F.lds + LDSCTL_OFF))[u] = 0u;
    __syncthreads();
    XcdBarrier bar = xcd_barrier_post((unsigned*)(F.ctl + CW_BAR) + args.li * XCD_BAR_WORDS, F.MISC + 8);
    const int lo = args.ph_lo, hi = args.ph_hi;
#define IN(k) (lo <= (k) && (k) < hi)
#define BOTH(k) (IN(k) && IN((k) + 1))
    if (IN(0)) { p0_prologue(F); if (BOTH(0)) xcd_barrier(bar); }
    if (IN(1)) {
        pg8::Gemm g{(const pg8::bf16_t*)(ws + WS_XN), (const pg8::bf16_t*)(ws + WS_WIN), M, NP, D_MODEL};
        pg8::StaticOrder S; S.init(M, NP, F.G, (int)blockIdx.x);
        EpiInproj E{(bf16_t*)(ws + WS_PROJ), (const float*)(ws + WS_COS), (const float*)(ws + WS_SIN), F.b_merge, (float*)(ws + WS_KPART)};
        pg8::gemm_phase<EpiInproj, pg8::StaticOrder, true, true>(F.lds + RING_OFF, g, S, E);
        if (BOTH(1)) xcd_barrier(bar);
    }
    if (IN(2)) {
        const attn_body::bf16* pj = (const attn_body::bf16*)(ws + WS_PROJ);
        const attn_body::AttnTensors AT{pj + P_MQ, pj + P_MK, pj + P_MV, pj + P_MG, (const float*)(ws + WS_KPART), (attn_body::bf16*)(ws + WS_OA)};
        const attn_body::StaticOrder SA((int)F.G, (int)blockIdx.x);
        attn_body::attn_phase<attn_body::StaticOrder>((char*)lds + RING_OFF, AT, SA);
    }
    const gla::Ctx GX{(const bf16_t*)(ws + WS_PROJ), (const float*)(ws + WS_GFG), F.w_fg2, F.b_fg, F.gla_norm_g, (const float*)(ws + WS_QKHP),
                      (bf16_t*)F.out, F.out + 8 * MiB, (bf16_t*)(F.out + 16 * MiB), (bf16_t*)(ws + WS_OB)};
    if (IN(3)) {
        for (int u = F.vcu; u < 32 * 64; u += F.G) gla::unit_a(F.lds, GX, u >> 6, u & 63, F.tid, F.lane, F.wave);
        if (BOTH(3)) xcd_barrier(bar);
    }
    if (IN(4)) {
        gla::scan_b(GX, F.vcu * (NWAVES * 64) + F.tid, F.G * NWAVES * 64);
        if (BOTH(4)) xcd_barrier(bar);
    }
    if (IN(5)) {
        for (int u = F.vcu; u < 32 * 64; u += F.G) gla::unit_c(F.lds, GX, u >> 6, u & 63, F.tid, F.lane, F.wave);
        if (BOTH(5)) xcd_barrier(bar);
    }
    if (IN(6)) {
        { pg8::Gemm g{(const pg8::bf16_t*)(ws + WS_OA), (const pg8::bf16_t*)(ws + WS_WA), M, 1024, 512};
          pg8::StaticOrder S; S.init(M, 1024, F.G, (int)blockIdx.x);
          EpiMerge<false> E{(const bf16_t*)(ws + WS_PROJ), (bf16_t*)(ws + WS_MERGED)};
          pg8::gemm_phase<EpiMerge<false>, pg8::StaticOrder, true, true>(F.lds + RING_OFF, g, S, E); }
        VM_WAIT(); __builtin_amdgcn_fence(__ATOMIC_ACQUIRE, "agent"); VM_WAIT(); __syncthreads();
        { pg8::Gemm g{(const pg8::bf16_t*)(ws + WS_OB), (const pg8::bf16_t*)(ws + WS_WB), M, 1024, 512};
          pg8::StaticOrder S; S.init(M, 1024, F.G, (int)blockIdx.x);
          EpiMerge<true> E{(const bf16_t*)(ws + WS_PROJ), (bf16_t*)(ws + WS_MERGED)};
          pg8::gemm_phase<EpiMerge<true>, pg8::StaticOrder, true, true>(F.lds + RING_OFF, g, S, E); }
        if (BOTH(6)) xcd_barrier(bar);
    }
    if (IN(7)) {
        pg8::Gemm g{(const pg8::bf16_t*)(ws + WS_MERGED), (const pg8::bf16_t*)(ws + WS_WO), M, 1024, 1024};
        pg8::StaticOrder S; S.init(M, 1024, F.G, (int)blockIdx.x);
        EpiOut E{F.x, F.out, (float*)(ws + WS_ROWSS)};
        pg8::gemm_phase<EpiOut, pg8::StaticOrder, true, true>(F.lds + RING_OFF, g, S, E);
        if (BOTH(7)) xcd_barrier(bar);
    }
    if (IN(8)) {
        const float* rowss = (const float*)(ws + WS_ROWSS);
        const int gw = F.vcu * NWAVES + F.wave, NGW = F.G * NWAVES;
        for (int m = gw; m < M; m += NGW) {
            float p = (F.lane < 16) ? rowss[(size_t)F.lane * M + m] : 0.f;
            p += __shfl_xor(p, 1); p += __shfl_xor(p, 2); p += __shfl_xor(p, 4); p += __shfl_xor(p, 8);
            const float rs = rsqrtf(__shfl(p, 0) * (1.f / D_MODEL) + RMS_EPS);
            GAS f32x4* xr = (GAS f32x4*)(F.out + (size_t)m * D_MODEL) + F.lane;
            const GAS f32x4* gr = (const GAS f32x4*)F.norm_f_g + F.lane;
#pragma unroll
            for (int j = 0; j < 4; ++j) xr[64 * j] = xr[64 * j] * rs * gr[64 * j];
        }
    }
#undef IN
#undef BOTH
}

extern "C" void kernel_launch(void* const* d_in, const int* in_sizes, int n_in, void* d_out, int out_size, void* d_ws, size_t ws_size, hipStream_t stream) {
    static int grid = 0;
    if (grid == 0) {
        if (n_in != 11 || in_sizes[0] != M * D_MODEL || out_size != M * D_MODEL || ws_size < WS_END) {
            fprintf(stderr, "kernel_launch: unexpected shapes n_in %d in0 %d out %d ws %zu\n", n_in, n_in > 0 ? in_sizes[0] : -1, out_size, ws_size); grid = -1; return; }
        int dev = 0, cus = 0;
        if (hipGetDevice(&dev) != hipSuccess || hipDeviceGetAttribute(&cus, hipDeviceAttributeMultiprocessorCount, dev) != hipSuccess) { grid = -1; return; }
        if (hipFuncSetAttribute((const void*)mk_fwd, hipFuncAttributeMaxDynamicSharedMemorySize, LDS_BYTES) != hipSuccess) { fprintf(stderr, "kernel_launch: hipFuncSetAttribute failed\n"); grid = -1; return; }
        (void)hipGetLastError();
        grid = cus;
    }
    if (grid < 0) return;
    unsigned char* ws = (unsigned char*)d_ws;
    hipMemsetAsync(ws + WS_CTL, 0, CTL_ZERO_BYTES, stream);
    Args a{};
    for (int i = 0; i < 11; ++i) a.in[i] = (const float*)d_in[i];
    a.out = (float*)d_out; a.ws = ws;
    auto launch_phases = [&](int lo, int hi, int li) { a.ph_lo = lo; a.ph_hi = hi; a.li = li; hipLaunchKernelGGL(mk_fwd, dim3(grid), dim3(NWAVES * 64), LDS_BYTES, stream, a); };
    for (int p = 0; p < 9; ++p) launch_phases(p, p + 1, p);
}
```
